# Optimizing an MI355X kernel written in HIP

```python
import jax, jax.numpy as jnp
from jax import lax
import numpy as np

D_MODEL = 1024
BATCH = 1
SEQ = 16384
DEPTH = 2
DEC_BATCH = 32
DEC_SEQ = 1
PAST_LEN = 16384
PAGE_SIZE = 128

MIX_WIDTH = D_MODEL
HEAD_DIM = 64
A_WIDTH = MIX_WIDTH // 4
A_GROUPS = A_WIDTH // HEAD_DIM
B_WIDTH = MIX_WIDTH - A_WIDTH
B_HEADS = B_WIDTH // HEAD_DIM
CHUNK = 128
PATTERNS = ((128, 1), (512, 4), (2048, 16))
WINDOW = 2048
Q_BLOCK = 128
_SIZES = (A_WIDTH, A_WIDTH, A_WIDTH, B_WIDTH, B_WIDTH, B_WIDTH, B_WIDTH)
PROJ_WIDTH = sum(_SIZES)
SPLIT_AT = tuple(sum(_SIZES[:i + 1]) for i in range(len(_SIZES) - 1))
EPS = 1e-6

kernel_name = "hymba_sgu_dilated_swa_decoder_step"


def rms_norm(x, g):
    xf = x.astype(jnp.float32)
    y = xf * lax.rsqrt(jnp.mean(xf * xf, axis=-1, keepdims=True) + EPS)
    return (y * g.astype(jnp.float32)).astype(x.dtype)


def alibi_slopes():
    return 2.0 ** (-8.0 * jnp.arange(1, B_HEADS + 1, dtype=jnp.float32) / B_HEADS)


def chunk_spatial_gate(u, v, sgu_g, w_s, b_s):
    bn, t, _ = v.shape
    n_chunks = -(-t // CHUNK)
    pad = n_chunks * CHUNK - t
    vn = rms_norm(v, sgu_g)
    vp = jnp.pad(vn, ((0, 0), (0, pad), (0, 0))).reshape(bn, n_chunks, CHUNK, A_GROUPS, HEAD_DIM)
    mask = jnp.tril(jnp.ones((CHUNK, CHUNK), dtype=bool))
    w = jnp.where(mask[None], w_s, jnp.zeros_like(w_s))
    mixed = jnp.einsum('gts,bcsgd->bctgd', w, vp) + b_s.T[None, None, :, :, None]
    mixed = mixed.reshape(bn, n_chunks * CHUNK, A_WIDTH)[:, :t]
    return u * mixed, vn


def dilated_attend(q, k, v, q_idx, slopes):
    outs, lses = [], []
    for win, dil in PATTERNS:
        j = jnp.arange(win // dil + 1)
        idx = q_idx[:, None] - j[None, :] * dil
        valid = idx >= 0
        idxc = jnp.maximum(idx, 0)
        kg = k[:, idxc]
        vg = v[:, idxc]
        s = jnp.einsum('bqhd,bqjhd->bqhj', q, kg, preferred_element_type=jnp.float32)
        dist = (j * dil).astype(jnp.float32)
        s = s - slopes[:, None] * dist[None, :]
        s = jnp.where(valid[None, :, None, :], s, -jnp.inf)
        m = jnp.max(s, axis=-1, keepdims=True)
        p = jnp.exp(s - m)
        den = jnp.sum(p, axis=-1, keepdims=True)
        o = jnp.einsum('bqhj,bqjhd->bqhd', (p / den).astype(v.dtype), vg,
                       preferred_element_type=jnp.float32)
        outs.append(o)
        lses.append((m + jnp.log(den))[..., 0])
    wts = jax.nn.softmax(jnp.stack(lses, axis=0), axis=0)
    out = jnp.einsum('pbqh,pbqhd->bqhd', wts, jnp.stack(outs, axis=0))
    return out.astype(q.dtype)


def mixer_inputs(x, norm_g, w_in, q_g, k_g):
    bn, t, _ = x.shape
    h = rms_norm(x, norm_g)
    p = jnp.einsum('btd,de->bte', h, w_in)
    ua, va, za, q, k, v, zb = jnp.split(p, SPLIT_AT, axis=-1)
    q = rms_norm(q.reshape(bn, t, B_HEADS, HEAD_DIM), q_g) * (HEAD_DIM ** -0.5)
    k = rms_norm(k.reshape(bn, t, B_HEADS, HEAD_DIM), k_g)
    v = v.reshape(bn, t, B_HEADS, HEAD_DIM)
    return ua, va, za, q, k, v, zb


def mixer_output(x, a, za, o, zb, w_out):
    bn, t, _ = x.shape
    a = a * jax.nn.silu(za)
    b = o.reshape(bn, t, B_WIDTH) * jax.nn.silu(zb)
    return x + jnp.einsum('bte,ed->btd', jnp.concatenate([a, b], axis=-1), w_out)


def setup_inputs(seed: int = 0) -> dict:
    key = jax.random.key(seed)
    ks = jax.random.split(key, 12)
    cache_len = min(WINDOW, PAST_LEN)
    f32 = jnp.float32
    return {
        "x_prompt": jax.random.normal(ks[0], (BATCH, SEQ, D_MODEL), f32),
        "x_sample": jax.random.normal(ks[1], (DEC_BATCH, DEC_SEQ, D_MODEL), f32),
        "cache_k": jax.random.normal(ks[2], (DEPTH, DEC_BATCH, cache_len, B_HEADS, HEAD_DIM), f32),
        "cache_v": jax.random.normal(ks[3], (DEPTH, DEC_BATCH, cache_len, B_HEADS, HEAD_DIM), f32),
        "norm_g": 1.0 + 0.02 * jax.random.normal(ks[4], (DEPTH, D_MODEL), f32),
        "w_in": jax.random.normal(ks[5], (DEPTH, D_MODEL, PROJ_WIDTH), f32) * D_MODEL ** -0.5,
        "sgu_g": 1.0 + 0.02 * jax.random.normal(ks[6], (DEPTH, A_WIDTH), f32),
        "w_spatial": jax.random.normal(ks[7], (DEPTH, A_GROUPS, CHUNK, CHUNK), f32) * CHUNK ** -0.5,
        "b_spatial": 0.1 * jax.random.normal(ks[8], (DEPTH, A_GROUPS, CHUNK), f32),
        "q_norm_g": 1.0 + 0.02 * jax.random.normal(ks[9], (DEPTH, HEAD_DIM), f32),
        "k_norm_g": 1.0 + 0.02 * jax.random.normal(ks[10], (DEPTH, HEAD_DIM), f32),
        "w_out": jax.random.normal(ks[11], (DEPTH, MIX_WIDTH, D_MODEL), f32) * MIX_WIDTH ** -0.5,
    }


def reference(x_prompt, x_sample, cache_k, cache_v, norm_g, w_in, sgu_g, w_spatial, b_spatial,
              q_norm_g, k_norm_g, w_out):
    slopes = alibi_slopes()
    xp, xs = x_prompt, x_sample
    bp, tp, _ = xp.shape
    bs, ts, _ = xs.shape
    n_blocks = tp // Q_BLOCK
    keep_p = min(WINDOW, tp)
    cache_len = cache_k.shape[2]
    kp_new, vp_new, ks_new, vs_new, sgu_new = [], [], [], [], []
    for l in range(DEPTH):
        ua, va, za, q, k, v, zb = mixer_inputs(xp, norm_g[l], w_in[l], q_norm_g[l], k_norm_g[l])
        a_out, _ = chunk_spatial_gate(ua, va, sgu_g[l], w_spatial[l], b_spatial[l])
        qb = q.reshape(bp, n_blocks, Q_BLOCK, B_HEADS, HEAD_DIM).transpose(1, 0, 2, 3, 4)

        def attend_block(args, k=k, v=v):
            q_blk, i = args
            q_idx = i * Q_BLOCK + jnp.arange(Q_BLOCK)
            return dilated_attend(q_blk, k, v, q_idx, slopes)

        ob = lax.map(attend_block, (qb, jnp.arange(n_blocks)))
        o = ob.transpose(1, 0, 2, 3, 4).reshape(bp, tp, B_HEADS, HEAD_DIM)
        kp_new.append(k[:, tp - keep_p:])
        vp_new.append(v[:, tp - keep_p:])
        xp = mixer_output(xp, a_out, za, o, zb, w_out[l])

        ua, va, za, q, k, v, zb = mixer_inputs(xs, norm_g[l], w_in[l], q_norm_g[l], k_norm_g[l])
        a_out, vn = chunk_spatial_gate(ua, va, sgu_g[l], w_spatial[l], b_spatial[l])
        k_ext = jnp.concatenate([cache_k[l].astype(k.dtype), k], axis=1)
        v_ext = jnp.concatenate([cache_v[l].astype(v.dtype), v], axis=1)
        o = dilated_attend(q, k_ext, v_ext, cache_len + jnp.arange(ts), slopes)
        ks_new.append(k)
        vs_new.append(v)
        sgu_new.append(vn)
        xs = mixer_output(xs, a_out, za, o, zb, w_out[l])

    new_k_prompt = jnp.stack(kp_new, axis=0)
    new_v_prompt = jnp.stack(vp_new, axis=0)
    new_k_sample = jnp.stack(ks_new, axis=0)
    new_v_sample = jnp.stack(vs_new, axis=0)
    new_sgu_v_sample = jnp.stack(sgu_new, axis=0)
    return (xp, xs, new_k_prompt, new_v_prompt, new_k_sample, new_v_sample, new_sgu_v_sample)
```

```cpp
#include <hip/hip_runtime.h>
#include <hip/hip_cooperative_groups.h>
#include <cstdio>
namespace cg = cooperative_groups;

#define LAS __attribute__((address_space(3)))
typedef unsigned short bf16_t;
typedef short bf16x8 __attribute__((ext_vector_type(8)));
typedef float f32x4 __attribute__((ext_vector_type(4)));
typedef float f32x16 __attribute__((ext_vector_type(16)));
typedef unsigned u32x2 __attribute__((ext_vector_type(2)));
typedef unsigned u32x4 __attribute__((ext_vector_type(4)));

constexpr int D_MODEL = 1024, SEQ = 16384, NS = 32, TTOK = SEQ + NS  , MPAD = 16640, PROJ = 3840, CACHE = 2048;
constexpr int NTHREADS = 512;
constexpr int LDS_BYTES = 140 * 1024;
constexpr float LOG2E = 1.4426950408889634f;

constexpr size_t O_YP = 0, O_YS = 16777216, O_KP = O_YS + 32768, O_VP = O_KP + 3145728, O_KS = O_VP + 3145728, O_VS = O_KS + 49152, O_SG = O_VS + 49152;

struct Params {
    const float *x_prompt, *x_sample, *cache_k, *cache_v, *norm_g, *w_in, *sgu_g, *w_sp, *b_sp, *qg, *kg, *w_out;
    float* out;
    unsigned char* ws;
    int phase_lo, phase_hi;
};
constexpr size_t al4k(size_t b) { return (b + 4095) & ~(size_t)4095; }
constexpr size_t WS_WINT = 0;
constexpr size_t WS_WOUTT = WS_WINT + al4k((size_t)2 * PROJ * 1024 * 2);
constexpr size_t WS_HB = WS_WOUTT + al4k((size_t)2 * 1024 * 1024 * 2);
constexpr size_t WS_P = WS_HB + al4k((size_t)MPAD * 1024 * 2);
constexpr size_t WS_VT1 = WS_P + al4k((size_t)MPAD * PROJ * 2);
constexpr size_t WS_VT2 = WS_VT1 + al4k((size_t)768 * SEQ * 2);
constexpr size_t WS_VT3 = WS_VT2 + al4k((size_t)768 * SEQ * 2);
constexpr size_t WS_G = WS_VT3 + al4k((size_t)768 * SEQ * 2);
constexpr size_t WS_X1 = WS_G + al4k((size_t)MPAD * 1024 * 2);
constexpr size_t WS_END = WS_X1 + al4k((size_t)TTOK * 1024 * 4);
#define WSP(p, T, OFF) ((T*)((p).ws + (OFF)))

__device__ __forceinline__ bf16_t f2bf(float f) { unsigned u = __float_as_uint(f); u += 0x7FFFu + ((u >> 16) & 1u); return (bf16_t)(u >> 16); }
__device__ __forceinline__ unsigned pk2(float lo, float hi) { return (unsigned)f2bf(lo) | ((unsigned)f2bf(hi) << 16); }
__device__ __forceinline__ float bf2f(bf16_t b) { return __uint_as_float(((unsigned)b) << 16); }
__device__ __forceinline__ float bflo(unsigned u) { return __uint_as_float(u << 16); }
__device__ __forceinline__ float bfhi(unsigned u) { return __uint_as_float(u & 0xFFFF0000u); }
__device__ __forceinline__ int opaque_tid() { int t = threadIdx.x; asm volatile("" : "+v"(t)); return t; }
__device__ __forceinline__ float silu(float x) { return x / (1.0f + __expf(-x)); }

namespace pg8 {
constexpr int BM = 256, BK = 64, HALF = 128, HTB = HALF * BK * 2, STAGE_BYTES = 8 * HTB, NXCD = 8, WGM = 8;
__device__ __forceinline__ int lds_byte(int r, int c) { const int st = (r >> 4) * 2 + (c >> 5), rr = r & 15, cc = c & 31, ob = rr * 64 + cc * 2; return st * 1024 + (ob ^ (((ob >> 9) & 1) << 5)); }
__device__ __forceinline__ void stage_rc(int b, int& R, int& C) { const int st = b / 1024, sb = b % 1024, swz = sb ^ (((sb >> 9) & 1) << 5); R = (st >> 1) * 16 + swz / 64; C = (st & 1) * 32 + (swz % 64) / 2; }
struct Unit { int pm, pn; };
struct Gemm { const bf16_t* A; const bf16_t* Bt; int K; };

struct Order {
    int nM, nN, nwg, G, c, i0, Loff, pm_add, pn_skip_from, pn_skip_by;
    __device__ bool next(int i, Unit& u) const {
        const long L = (long)(i + i0) * G + c - Loff; if (L < 0 || L >= nwg) return false;
        int wgid = (int)L; { const int q = nwg / NXCD, r = nwg % NXCD, xcd = wgid % NXCD, off = wgid / NXCD; wgid = (xcd < r ? xcd * (q + 1) : r * (q + 1) + (xcd - r) * q) + off; }
        const int nig = WGM * nN, gid = wgid / nig, fm = gid * WGM, gsz = (nM - fm) < WGM ? (nM - fm) : WGM;
        u.pm = fm + ((wgid % nig) % gsz) + pm_add; int pn = (wgid % nig) / gsz; if (pn >= pn_skip_from) pn += pn_skip_by; u.pn = pn; return true;
    }
};

template <class Epi>
__device__ __forceinline__ void gemm_phase(LAS unsigned char* lds, const Gemm g, const Order& S, const Epi& E) {
    const int tid = opaque_tid(), wid = __builtin_amdgcn_readfirstlane(tid >> 6), lane = tid & 63, wr = wid >> 2, wc = wid & 3, fr = lane & 15, fq = lane >> 4;
    const int K = g.K, nt = K / BK;
    unsigned voffA[2], voffB[2];
#pragma unroll
    for (int i = 0; i < 2; ++i) { int R, C; stage_rc(tid * 16 + i * 8192, R, C); const int Rb = Epi::BPERM ? (64 * (R >> 5) + (R & 31)) : R;
        voffA[i] = (unsigned)(R * K + C) * 2u; voffB[i] = (unsigned)(Rb * K + C) * 2u; }
    const size_t kstep = (size_t)(BK * 2);
    const size_t hstep = (size_t)HALF * K * 2;
    const size_t hstepB = Epi::BPERM ? (size_t)32 * K * 2 : hstep;
    const size_t tstep = 2 * hstep;
    const unsigned ldsw = (unsigned)wid * 1024u;
    const int aoff = lds_byte(wr * 64 + fr, fq * 8), boff = lds_byte(wc * 32 + fr, fq * 8);
#define PG8_SA(b, h) (((b) * 2 + (h)) * HTB)
#define PG8_SB(b, h) ((4 + (b) * 2 + (h)) * HTB)
#define PG8_STAGE(bufoff, gbase, voff) do { _Pragma("unroll") for (int _i = 0; _i < 2; ++_i) \
        __builtin_amdgcn_global_load_lds((const unsigned*)((const char*)(gbase) + (voff)[_i]), (LAS unsigned*)(lds + (bufoff) + ldsw + _i * 8192), 16, 0, 0); } while (0)
#define PG8_LDA(dst, b, h) do { _Pragma("unroll") for (int m = 0; m < 4; ++m) _Pragma("unroll") for (int k = 0; k < 2; ++k) dst[m][k] = *(const LAS bf16x8*)(lds + PG8_SA(b, h) + aoff + m * 2048 + k * 1024); } while (0)
#define PG8_LDB(dst, b, h) do { _Pragma("unroll") for (int n = 0; n < 2; ++n) _Pragma("unroll") for (int k = 0; k < 2; ++k) dst[n][k] = *(const LAS bf16x8*)(lds + PG8_SB(b, h) + boff + n * 2048 + k * 1024); } while (0)
#define PG8_MMA(ai, bj, At, Bt) do { __builtin_amdgcn_s_setprio(1); _Pragma("unroll") for (int m = 0; m < 4; ++m) _Pragma("unroll") for (int n = 0; n < 2; ++n) _Pragma("unroll") for (int k = 0; k < 2; ++k) \
        acc[ai][bj][m][n] = __builtin_amdgcn_mfma_f32_16x16x32_bf16(Bt[n][k], At[m][k], acc[ai][bj][m][n], 0, 0, 0); __builtin_amdgcn_s_setprio(0); } while (0)
#define PG8_WAIT_V(n) asm volatile("s_waitcnt vmcnt(" #n ")" ::: "memory")
#define PG8_WAIT_L(n) asm volatile("s_waitcnt lgkmcnt(" #n ")" ::: "memory")
#define PG8_BAR __builtin_amdgcn_s_barrier()
#define PG8_SCHED __builtin_amdgcn_sched_barrier(0)
    Unit cur, nxt; int ui = 0;
    if (!S.next(0, cur)) return;
    f32x4 acc[2][2][4][2];
#pragma unroll
    for (int a = 0; a < 2; ++a)
#pragma unroll
        for (int b = 0; b < 2; ++b)
#pragma unroll
            for (int m = 0; m < 4; ++m)
#pragma unroll
                for (int n = 0; n < 2; ++n) acc[a][b][m][n] = (f32x4){0.f, 0.f, 0.f, 0.f};
    bf16x8 At[4][2], B0[2][2], B1[2][2];
    const char* cA = (const char*)g.A + (size_t)cur.pm * tstep; const char* cB = (const char*)g.Bt + (size_t)cur.pn * tstep;
    PG8_STAGE(PG8_SB(0, 0), cB, voffB); PG8_STAGE(PG8_SA(0, 0), cA, voffA); PG8_STAGE(PG8_SB(0, 1), cB + hstepB, voffB); PG8_STAGE(PG8_SA(0, 1), cA + hstep, voffA);
    if (wr == 1) PG8_BAR;
    PG8_WAIT_V(4); PG8_BAR;
    PG8_STAGE(PG8_SB(1, 0), cB + kstep, voffB); PG8_STAGE(PG8_SA(1, 0), cA + kstep, voffA); PG8_STAGE(PG8_SB(1, 1), cB + hstepB + kstep, voffB);
    PG8_WAIT_V(6); PG8_BAR;
    for (;;) {
        const bool has_next = S.next(ui + 1, nxt);
        const char* nA = has_next ? (const char*)g.A + (size_t)nxt.pm * tstep : cA; const char* nB = has_next ? (const char*)g.Bt + (size_t)nxt.pn * tstep : cB;
        for (int t = 0; t < nt; t += 2) {
            const bool last = (t == nt - 2);
            const char* a1 = cA + (size_t)(t + 1) * kstep;
            const char* a2 = last ? nA : cA + (size_t)(t + 2) * kstep; const char* b2 = last ? nB : cB + (size_t)(t + 2) * kstep;
            const char* a3 = a2 + kstep; const char* b3 = b2 + kstep;
            PG8_LDB(B0, 0, 0); PG8_SCHED; PG8_LDA(At, 0, 0); PG8_STAGE(PG8_SA(1, 1), a1 + hstep, voffA);
            PG8_WAIT_L(8); PG8_BAR; PG8_WAIT_L(0); PG8_MMA(0, 0, At, B0); PG8_BAR; PG8_SCHED;
            PG8_LDB(B1, 0, 1); PG8_STAGE(PG8_SB(0, 0), b2, voffB);
            PG8_BAR; PG8_WAIT_L(0); PG8_MMA(0, 1, At, B1); PG8_BAR;
            PG8_LDA(At, 0, 1); PG8_STAGE(PG8_SA(0, 0), a2, voffA);
            PG8_BAR; PG8_WAIT_L(0); PG8_MMA(1, 0, At, B0); PG8_BAR; PG8_SCHED;
            PG8_STAGE(PG8_SB(0, 1), b2 + hstepB, voffB);
            PG8_WAIT_V(6); PG8_BAR; PG8_MMA(1, 1, At, B1); PG8_BAR;
            PG8_LDB(B0, 1, 0); PG8_SCHED; PG8_LDA(At, 1, 0); PG8_STAGE(PG8_SA(0, 1), a2 + hstep, voffA);
            PG8_WAIT_L(8); PG8_BAR; PG8_WAIT_L(0); PG8_MMA(0, 0, At, B0); PG8_BAR; PG8_SCHED;
            PG8_LDB(B1, 1, 1); PG8_STAGE(PG8_SB(1, 0), b3, voffB);
            PG8_BAR; PG8_WAIT_L(0); PG8_MMA(0, 1, At, B1); PG8_BAR;
            PG8_LDA(At, 1, 1); PG8_STAGE(PG8_SA(1, 0), a3, voffA);
            PG8_BAR; PG8_WAIT_L(0); PG8_MMA(1, 0, At, B0); PG8_BAR; PG8_SCHED;
            PG8_STAGE(PG8_SB(1, 1), b3 + hstepB, voffB);
            PG8_WAIT_V(6); PG8_BAR; PG8_MMA(1, 1, At, B1); PG8_BAR;
        }
        E(acc, cur, wr, wc, fr, fq);
        if (!has_next) break;
#pragma unroll
        for (int a = 0; a < 2; ++a)
#pragma unroll
            for (int b = 0; b < 2; ++b)
#pragma unroll
                for (int m = 0; m < 4; ++m)
#pragma unroll
                    for (int n = 0; n < 2; ++n) acc[a][b][m][n] = (f32x4){0.f, 0.f, 0.f, 0.f};
        cur = nxt; cA = nA; cB = nB; ++ui;
    }
    PG8_WAIT_V(0);
    if (wr == 0) PG8_BAR;
    PG8_BAR;
#undef PG8_SA
#undef PG8_SB
#undef PG8_STAGE
#undef PG8_LDA
#undef PG8_LDB
#undef PG8_MMA
#undef PG8_WAIT_V
#undef PG8_WAIT_L
#undef PG8_BAR
#undef PG8_SCHED
}
}
using pg8::Unit;

struct EpiIn {
    static constexpr bool BPERM = true;
    bf16_t* P; const float* qg; const float* kg; float* outk_p; float* outk_s;
    __device__ __forceinline__ void operator()(const f32x4 (&acc)[2][2][4][2], const Unit& u, int wr, int wc, int fr, int fq) const {
        const int pn = u.pn;
        const int kind = (pn >= 3 && pn < 6) ? 1 : ((pn >= 6 && pn < 9) ? 2 : 0);
        const int colw = pn * 256 + wc * 64 + 4 * fq;
        f32x4 gv[2][2];
        const float* gp = kind == 1 ? qg : kg;
#pragma unroll
        for (int bj = 0; bj < 2; ++bj)
#pragma unroll
            for (int n = 0; n < 2; ++n) {
                if (kind) { gv[bj][n] = *(const f32x4*)(gp + 32 * bj + 16 * n + 4 * fq); if (kind == 1) gv[bj][n] = gv[bj][n] * 0.125f; }
                else gv[bj][n] = (f32x4){1.f, 1.f, 1.f, 1.f};
            }
#pragma unroll
        for (int ai = 0; ai < 2; ++ai)
#pragma unroll
            for (int m = 0; m < 4; ++m) {
                const int r = u.pm * 256 + ai * 128 + wr * 64 + m * 16 + fr;
                float rstd = 1.0f;
                if (kind) {
                    float ss = 0.f;
#pragma unroll
                    for (int bj = 0; bj < 2; ++bj)
#pragma unroll
                        for (int n = 0; n < 2; ++n)
#pragma unroll
                            for (int e = 0; e < 4; ++e) ss += acc[ai][bj][m][n][e] * acc[ai][bj][m][n][e];
                    ss += __shfl_xor(ss, 16); ss += __shfl_xor(ss, 32);
                    rstd = rsqrtf(ss * (1.0f / 64.0f) + 1e-6f);
                }
                const bool ok = r < TTOK;
#pragma unroll
                for (int bj = 0; bj < 2; ++bj)
#pragma unroll
                    for (int n = 0; n < 2; ++n) {
                        const f32x4 v = acc[ai][bj][m][n] * gv[bj][n] * rstd;
                        const int col = colw + 32 * bj + 16 * n;
                        if (ok) { u32x2 o; o[0] = pk2(v[0], v[1]); o[1] = pk2(v[2], v[3]); *(u32x2*)(P + (size_t)r * PROJ + col) = o; }
                        if (kind == 2) {
                            const int kc = col - 1536;
                            if (r >= SEQ - CACHE && r < SEQ) *(f32x4*)(outk_p + (size_t)(r - (SEQ - CACHE)) * 768 + kc) = v;
                            else if (r >= SEQ && r < TTOK) *(f32x4*)(outk_s + (size_t)(r - SEQ) * 768 + kc) = v;
                        }
                    }
            }
    }
};
struct EpiV {
    static constexpr bool BPERM = false;
    bf16_t *VT1, *VT2, *VT3; float* outv_p; float* outv_s;
    __device__ __forceinline__ void operator()(const f32x4 (&acc)[2][2][4][2], const Unit& u, int wr, int wc, int fr, int fq) const {
#pragma unroll
        for (int ai = 0; ai < 2; ++ai)
#pragma unroll
            for (int m = 0; m < 4; ++m) {
                const int fv = u.pm * 256 + ai * 128 + wr * 64 + m * 16 + fr - 2304;
#pragma unroll
                for (int bj = 0; bj < 2; ++bj)
#pragma unroll
                    for (int n = 0; n < 2; ++n) {
                        const int t0 = u.pn * 256 + bj * 128 + wc * 32 + n * 16 + 4 * fq;
                        const f32x4 v = acc[ai][bj][m][n];
                        if (t0 < SEQ) {
                            u32x2 o; o[0] = pk2(v[0], v[1]); o[1] = pk2(v[2], v[3]);
                            *(u32x2*)(VT1 + (size_t)fv * SEQ + t0) = o;
#pragma unroll
                            for (int e = 0; e < 4; ++e) {
                                const bf16_t b = f2bf(v[e]);
                                VT2[(size_t)fv * SEQ + e * 4096 + (t0 >> 2)] = b;
                                VT3[(size_t)fv * SEQ + ((t0 & 15) + e) * 1024 + (t0 >> 4)] = b;
                            }
                            if (t0 >= SEQ - CACHE) {
#pragma unroll
                                for (int e = 0; e < 4; ++e) outv_p[(size_t)(t0 + e - (SEQ - CACHE)) * 768 + fv] = v[e];
                            }
                        } else if (t0 < TTOK) {
#pragma unroll
                            for (int e = 0; e < 4; ++e) outv_s[(size_t)(t0 + e - SEQ) * 768 + fv] = v[e];
                        }
                    }
            }
    }
};
struct EpiOut {
    static constexpr bool BPERM = false;
    const float* xin_p; const float* xin_s; float* xo_p; float* xo_s;
    __device__ __forceinline__ void operator()(const f32x4 (&acc)[2][2][4][2], const Unit& u, int wr, int wc, int fr, int fq) const {
#pragma unroll
        for (int ai = 0; ai < 2; ++ai)
#pragma unroll
            for (int m = 0; m < 4; ++m) {
                const int r = u.pm * 256 + ai * 128 + wr * 64 + m * 16 + fr;
                if (r < TTOK) {
                    const float* xi = r < SEQ ? xin_p + (size_t)r * 1024 : xin_s + (size_t)(r - SEQ) * 1024;
                    float* xo = r < SEQ ? xo_p + (size_t)r * 1024 : xo_s + (size_t)(r - SEQ) * 1024;
#pragma unroll
                    for (int bj = 0; bj < 2; ++bj)
#pragma unroll
                        for (int n = 0; n < 2; ++n) {
                            const int c = u.pn * 256 + bj * 128 + wc * 32 + n * 16 + 4 * fq;
                            *(f32x4*)(xo + c) = *(const f32x4*)(xi + c) + acc[ai][bj][m][n];
                        }
                }
            }
    }
};

__device__ void transpose_tile(const float* __restrict__ src, bf16_t* __restrict__ dst, int K, int N, int tile_id, float* tile) {
    const int tilesN = N / 64, kb = (tile_id / tilesN) * 64, nb = (tile_id % tilesN) * 64, tid = opaque_tid();
    { const int n = tid & 63, k0 = tid >> 6;
#pragma unroll
      for (int i = 0; i < 8; ++i) { const int k = k0 + 8 * i; tile[k * 65 + n] = src[(size_t)(kb + k) * N + nb + n]; } }
    __syncthreads();
    { const int k = tid & 63, n0 = tid >> 6;
#pragma unroll
      for (int i = 0; i < 8; ++i) { const int n = n0 + 8 * i; dst[(size_t)(nb + n) * K + kb + k] = f2bf(tile[k * 65 + n]); } }
    __syncthreads();
}

__device__ void rmsnorm_rows(const Params& p, int layer) {
    const int tid = opaque_tid(), lane = tid & 63, wg = blockIdx.x * 8 + (tid >> 6), nw = gridDim.x * 8;
    const float* g = p.norm_g + layer * 1024;
    for (int row = wg; row < TTOK; row += nw) {
        const float* src = layer == 0 ? (row < SEQ ? p.x_prompt + (size_t)row * 1024 : p.x_sample + (size_t)(row - SEQ) * 1024) : WSP(p, float, WS_X1) + (size_t)row * 1024;
        f32x4 v[4]; float ss = 0.f;
#pragma unroll
        for (int i = 0; i < 4; ++i) { v[i] = *(const f32x4*)(src + i * 256 + lane * 4); ss += v[i][0] * v[i][0] + v[i][1] * v[i][1] + v[i][2] * v[i][2] + v[i][3] * v[i][3]; }
#pragma unroll
        for (int o = 32; o >= 1; o >>= 1) ss += __shfl_xor(ss, o);
        const float rstd = rsqrtf(ss * (1.0f / 1024.0f) + 1e-6f);
#pragma unroll
        for (int i = 0; i < 4; ++i) { const f32x4 gv = *(const f32x4*)(g + i * 256 + lane * 4); const f32x4 y = v[i] * rstd * gv;
            u32x2 o; o[0] = pk2(y[0], y[1]); o[1] = pk2(y[2], y[3]); *(u32x2*)(WSP(p, bf16_t, WS_HB) + (size_t)row * 1024 + i * 256 + lane * 4) = o; }
    }
}

__device__ void attn_item(const Params& p, int layer, int sb, int h, float* accL, float Mref2) {
    const int tid = opaque_tid(), w = tid >> 6, lane = tid & 63, c = lane & 31, hh = lane >> 5;
    const int T0 = sb * 512;
    const float sl2 = exp2f(-8.0f * (float)(h + 1) / 12.0f) * LOG2E;
    const bf16_t* P = WSP(p, bf16_t, WS_P);
    for (int pat = 0; pat < 3; ++pat) {
        const int ldil = 2 * pat, dil = 1 << ldil;
        const bf16_t* VT = pat == 0 ? WSP(p, bf16_t, WS_VT1) : (pat == 1 ? WSP(p, bf16_t, WS_VT2) : WSP(p, bf16_t, WS_VT3));
        for (int tt = 0; tt < 2; ++tt) {
            const int tl = w + 8 * tt;
            const int qb = pat == 0 ? 32 * tl : (pat == 1 ? 128 * (tl >> 2) + (tl & 3) : tl);
            const int qbase = T0 + qb;
            const int vidx0 = qbase >> ldil;
            const int res = qbase & (dil - 1);
            bf16x8 qf[4];
            { const bf16_t* qp = P + (size_t)(qbase + dil * c) * PROJ + 768 + h * 64 + 8 * hh;
#pragma unroll
              for (int s = 0; s < 4; ++s) qf[s] = *(const bf16x8*)(qp + 16 * s); }
            const bf16_t* vrow = VT + (size_t)(h * 64 + c) * SEQ + (size_t)res * (SEQ >> ldil);
            f32x16 O0, O1;
#pragma unroll
            for (int r = 0; r < 16; ++r) { O0[r] = 0.f; O1[r] = 0.f; }
            float den = 0.f;
            const float dsl = sl2 * (float)dil;
#pragma unroll 1
            for (int kt = 0; kt < 5; ++kt) {
                const int kk0 = -128 + 32 * kt;
                if (vidx0 + kk0 + 31 < 0) continue;
                int kpos = qbase + dil * (kk0 + c); kpos = kpos < 0 ? 0 : kpos;
                const bf16_t* kp = P + (size_t)kpos * PROJ + 1536 + h * 64 + 8 * hh;
                bf16x8 kf[4];
#pragma unroll
                for (int s = 0; s < 4; ++s) kf[s] = *(const bf16x8*)(kp + 16 * s);
                u32x2 vlo[2][2], vhi[2][2];
#pragma unroll
                for (int s2 = 0; s2 < 2; ++s2) {
                    int i0 = vidx0 + kk0 + 16 * s2 + 4 * hh; int i1 = i0 + 8; i0 = i0 < 0 ? 0 : i0; i1 = i1 < 0 ? 0 : i1;
#pragma unroll
                    for (int mt = 0; mt < 2; ++mt) { vlo[mt][s2] = *(const u32x2*)(vrow + (size_t)(32 * mt) * SEQ + i0); vhi[mt][s2] = *(const u32x2*)(vrow + (size_t)(32 * mt) * SEQ + i1); }
                }
                f32x16 S;
#pragma unroll
                for (int r = 0; r < 16; ++r) S[r] = 0.f;
#pragma unroll
                for (int s = 0; s < 4; ++s) S = __builtin_amdgcn_mfma_f32_32x32x16_bf16(kf[s], qf[s], S, 0, 0, 0);
#pragma unroll
                for (int r = 0; r < 16; ++r) {
                    const int row = (r & 3) + 8 * (r >> 2) + 4 * hh; const int kk = kk0 + row; const int dd = c - kk;
                    const bool valid = (dd >= 0) && (dd <= 128) && (vidx0 + kk >= 0);
                    const float e = S[r] * LOG2E - dsl * (float)dd - Mref2;
                    const float pv = valid ? __builtin_amdgcn_exp2f(e) : 0.f;
                    den += pv; S[r] = pv;
                }
#pragma unroll
                for (int s2 = 0; s2 < 2; ++s2) {
                    u32x4 pw;
#pragma unroll
                    for (int j = 0; j < 4; ++j) pw[j] = pk2(S[8 * s2 + 2 * j], S[8 * s2 + 2 * j + 1]);
                    const bf16x8 pf = __builtin_bit_cast(bf16x8, pw);
                    { u32x4 vw; vw[0] = vlo[0][s2][0]; vw[1] = vlo[0][s2][1]; vw[2] = vhi[0][s2][0]; vw[3] = vhi[0][s2][1];
                      O0 = __builtin_amdgcn_mfma_f32_32x32x16_bf16(__builtin_bit_cast(bf16x8, vw), pf, O0, 0, 0, 0); }
                    { u32x4 vw; vw[0] = vlo[1][s2][0]; vw[1] = vlo[1][s2][1]; vw[2] = vhi[1][s2][0]; vw[3] = vhi[1][s2][1];
                      O1 = __builtin_amdgcn_mfma_f32_32x32x16_bf16(__builtin_bit_cast(bf16x8, vw), pf, O1, 0, 0, 0); }
                }
            }
            den += __shfl_xor(den, 32);
            float* arow = accL + (qb + dil * c) * 65;
            if (pat == 0) {
#pragma unroll
                for (int r = 0; r < 16; ++r) { const int d = (r & 3) + 8 * (r >> 2) + 4 * hh; arow[d] = O0[r]; arow[32 + d] = O1[r]; }
                if (hh == 0) arow[64] = den;
            } else {
#pragma unroll
                for (int r = 0; r < 16; ++r) { const int d = (r & 3) + 8 * (r >> 2) + 4 * hh; arow[d] += O0[r]; arow[32 + d] += O1[r]; }
                if (hh == 0) arow[64] += den;
            }
        }
        __syncthreads();
    }
    for (int idx = tid; idx < 512 * 32; idx += NTHREADS) {
        const int ql = idx >> 5, d2 = (idx & 31) * 2;
        const float inv = 1.0f / accL[ql * 65 + 64];
        const size_t pos = (size_t)(T0 + ql);
        const unsigned zb = *(const unsigned*)(P + pos * PROJ + 3072 + h * 64 + d2);
        const float o0 = accL[ql * 65 + d2] * inv * silu(bflo(zb)), o1 = accL[ql * 65 + d2 + 1] * inv * silu(bfhi(zb));
        *(unsigned*)(WSP(p, bf16_t, WS_G) + pos * 1024 + 256 + h * 64 + d2) = pk2(o0, o1);
    }
    __syncthreads();
}

__device__ void sgu_item(const Params& p, int layer, int ch, int g, bf16_t* vnT  ) {
    const int tid = opaque_tid(), w = tid >> 6, lane = tid & 63, c = lane & 31, hh = lane >> 5;
    const int R0 = ch * 128;
    const bf16_t* P = WSP(p, bf16_t, WS_P);
    const float* sg = p.sgu_g + layer * 256;
    for (int rr = 0; rr < 16; ++rr) {
        const int row = w * 16 + rr;
        const u32x2 v = *(const u32x2*)(P + (size_t)(R0 + row) * PROJ + 256 + lane * 4);
        const float f0 = bflo(v[0]), f1 = bfhi(v[0]), f2 = bflo(v[1]), f3 = bfhi(v[1]);
        float ss = f0 * f0 + f1 * f1 + f2 * f2 + f3 * f3;
#pragma unroll
        for (int o = 32; o >= 1; o >>= 1) ss += __shfl_xor(ss, o);
        const float rstd = rsqrtf(ss * (1.0f / 256.0f) + 1e-6f);
        if ((lane >> 4) == g) {
            const int dl = (lane & 15) * 4; const f32x4 gv = *(const f32x4*)(sg + g * 64 + dl);
            vnT[(dl + 0) * 136 + row] = f2bf(f0 * rstd * gv[0]); vnT[(dl + 1) * 136 + row] = f2bf(f1 * rstd * gv[1]);
            vnT[(dl + 2) * 136 + row] = f2bf(f2 * rstd * gv[2]); vnT[(dl + 3) * 136 + row] = f2bf(f3 * rstd * gv[3]);
        }
    }
    __syncthreads();
    const int tt = w >> 1, dt = w & 1;
    f32x16 acc;
#pragma unroll
    for (int r = 0; r < 16; ++r) acc[r] = 0.f;
    const int t = 32 * tt + c;
    const float* wrow = p.w_sp + ((size_t)(layer * 4 + g) * 128 + t) * 128;
    for (int ks = 0; ks <= 2 * tt + 1; ++ks) {
        const int s0 = 16 * ks + 8 * hh;
        const f32x4 w0 = *(const f32x4*)(wrow + s0), w1 = *(const f32x4*)(wrow + s0 + 4);
        u32x4 aw;
        aw[0] = pk2(s0 + 0 <= t ? w0[0] : 0.f, s0 + 1 <= t ? w0[1] : 0.f); aw[1] = pk2(s0 + 2 <= t ? w0[2] : 0.f, s0 + 3 <= t ? w0[3] : 0.f);
        aw[2] = pk2(s0 + 4 <= t ? w1[0] : 0.f, s0 + 5 <= t ? w1[1] : 0.f); aw[3] = pk2(s0 + 6 <= t ? w1[2] : 0.f, s0 + 7 <= t ? w1[3] : 0.f);
        const bf16x8 bfrag = *(const bf16x8*)(vnT + (32 * dt + c) * 136 + s0);
        acc = __builtin_amdgcn_mfma_f32_32x32x16_bf16(__builtin_bit_cast(bf16x8, aw), bfrag, acc, 0, 0, 0);
    }
    const float* bsp = p.b_sp + (size_t)(layer * 4 + g) * 128;
    const int colA = g * 64 + 32 * dt + c;
#pragma unroll
    for (int r = 0; r < 16; ++r) {
        const int tr = 32 * tt + (r & 3) + 8 * (r >> 2) + 4 * hh;
        const float mixed = acc[r] + bsp[tr];
        const size_t row = (size_t)(R0 + tr);
        const float ua = bf2f(P[row * PROJ + colA]), za = bf2f(P[row * PROJ + 512 + colA]);
        WSP(p, bf16_t, WS_G)[row * 1024 + colA] = f2bf(ua * mixed * silu(za));
    }
    __syncthreads();
}

__device__ void sattn_item(const Params& p, int layer, int b, int h, float* sm, float Mref) {
    const int tid = opaque_tid(), lane = tid & 63;
    float* sc = sm;
    float* part = sm + 512;
    float* dsum = sm + 1024;
    const float slope = exp2f(-8.0f * (float)(h + 1) / 12.0f);
    const size_t tok = (size_t)(SEQ + b);
    const float* ck = p.cache_k + ((size_t)(layer * NS + b) * CACHE) * 768 + h * 64;
    const float* cv = p.cache_v + ((size_t)(layer * NS + b) * CACHE) * 768 + h * 64;
    const float* nk = p.out + O_KS + ((size_t)(layer * NS + b)) * 768 + h * 64;
    const float* nv = p.out + O_VS + ((size_t)(layer * NS + b)) * 768 + h * 64;
    const int sub = tid & 15, grp = tid >> 4;
    f32x4 q4;
    { const u32x2 qv = *(const u32x2*)(WSP(p, bf16_t, WS_P) + tok * PROJ + 768 + h * 64 + sub * 4); q4[0] = bflo(qv[0]); q4[1] = bfhi(qv[0]); q4[2] = bflo(qv[1]); q4[3] = bfhi(qv[1]); }
    for (int e0 = 0; e0 < 416; e0 += 32) {
        const int e = e0 + grp; const bool act = e < 387;
        const int ee = act ? e : 0; const int pat = ee / 129, j = ee - pat * 129; const int dist = j << (2 * pat);
        const float* kr = dist == 0 ? nk : ck + (size_t)(CACHE - dist) * 768;
        const f32x4 k4 = *(const f32x4*)(kr + sub * 4);
        float d = q4[0] * k4[0] + q4[1] * k4[1] + q4[2] * k4[2] + q4[3] * k4[3];
        d += __shfl_xor(d, 1); d += __shfl_xor(d, 2); d += __shfl_xor(d, 4); d += __shfl_xor(d, 8);
        if (act && sub == 0) sc[e] = __expf(d - slope * (float)dist - Mref);
    }
    __syncthreads();
    {
        const int d = tid & 63, kg = tid >> 6;
        float accv = 0.f, ds = 0.f;
        for (int e = kg; e < 387; e += 8) {
            const int pat = e / 129, j = e - pat * 129; const int dist = j << (2 * pat);
            const float* vr = dist == 0 ? nv : cv + (size_t)(CACHE - dist) * 768;
            const float pe = sc[e];
            accv += pe * vr[d]; ds += pe;
        }
        part[kg * 64 + d] = accv; if (d == 0) dsum[kg] = ds;
    }
    __syncthreads();
    if (tid < 64) {
        float num = 0.f, den = 0.f;
#pragma unroll
        for (int k = 0; k < 8; ++k) { num += part[k * 64 + tid]; den += dsum[k]; }
        const float zb = bf2f(WSP(p, bf16_t, WS_P)[tok * PROJ + 3072 + h * 64 + tid]);
        WSP(p, bf16_t, WS_G)[tok * 1024 + 256 + h * 64 + tid] = f2bf(num / den * silu(zb));
    }
    __syncthreads();
    (void)lane;
}

__device__ void ssgu_item(const Params& p, int layer) {
    const int tid = opaque_tid(), w = tid >> 6, lane = tid & 63;
    const float* sg = p.sgu_g + layer * 256;
    for (int rr = 0; rr < 4; ++rr) {
        const int b = w * 4 + rr; const size_t tok = (size_t)(SEQ + b);
        const u32x2 v = *(const u32x2*)(WSP(p, bf16_t, WS_P) + tok * PROJ + 256 + lane * 4);
        float f[4] = {bflo(v[0]), bfhi(v[0]), bflo(v[1]), bfhi(v[1])};
        float ss = f[0] * f[0] + f[1] * f[1] + f[2] * f[2] + f[3] * f[3];
#pragma unroll
        for (int o = 32; o >= 1; o >>= 1) ss += __shfl_xor(ss, o);
        const float rstd = rsqrtf(ss * (1.0f / 256.0f) + 1e-6f);
        const int g = lane >> 4;
        const float w00 = p.w_sp[(size_t)(layer * 4 + g) * 128 * 128], b0 = p.b_sp[(size_t)(layer * 4 + g) * 128];
        const u32x2 uav = *(const u32x2*)(WSP(p, bf16_t, WS_P) + tok * PROJ + lane * 4), zav = *(const u32x2*)(WSP(p, bf16_t, WS_P) + tok * PROJ + 512 + lane * 4);
        const float ua[4] = {bflo(uav[0]), bfhi(uav[0]), bflo(uav[1]), bfhi(uav[1])}, za[4] = {bflo(zav[0]), bfhi(zav[0]), bflo(zav[1]), bfhi(zav[1])};
        const f32x4 gv = *(const f32x4*)(sg + lane * 4);
        f32x4 vn; float o[4];
#pragma unroll
        for (int e = 0; e < 4; ++e) { vn[e] = f[e] * rstd * gv[e]; o[e] = ua[e] * (w00 * vn[e] + b0) * silu(za[e]); }
        *(f32x4*)(p.out + O_SG + ((size_t)(layer * NS + b)) * 256 + lane * 4) = vn;
        u32x2 go; go[0] = pk2(o[0], o[1]); go[1] = pk2(o[2], o[3]);
        *(u32x2*)(WSP(p, bf16_t, WS_G) + tok * 1024 + lane * 4) = go;
    }
}

__global__ void __launch_bounds__(NTHREADS, 2) hymba_fwd(Params p) {
    extern __shared__ __attribute__((aligned(16))) unsigned char shm[];
    cg::grid_group grid = cg::this_grid();
    const int G = gridDim.x, c = blockIdx.x;
    for (int ph = p.phase_lo; ph < p.phase_hi; ++ph) {
        if (ph > p.phase_lo) grid.sync();
        const int layer = ph >> 2, kind = ph & 3;
        if (kind == 0) {
            if (layer == 0) {
                float* tile = (float*)shm;
                for (int t = c; t < 2432; t += G) {
                    int tt = t; const int l = tt / 1216; tt -= l * 1216;
                    if (tt < 960) transpose_tile(p.w_in + (size_t)l * 1024 * PROJ, WSP(p, bf16_t, WS_WINT) + (size_t)l * PROJ * 1024, 1024, PROJ, tt, tile);
                    else transpose_tile(p.w_out + (size_t)l * 1024 * 1024, WSP(p, bf16_t, WS_WOUTT) + (size_t)l * 1024 * 1024, 1024, 1024, tt - 960, tile);
                }
            }
            rmsnorm_rows(p, layer);
        } else if (kind == 1) {
            LAS unsigned char* lds = (LAS unsigned char*)shm;
            const bf16_t* W = WSP(p, bf16_t, WS_WINT) + (size_t)layer * PROJ * 1024;
            {
                pg8::Order S; S.nM = 65; S.nN = 12; S.nwg = 780; S.G = G; S.c = c; S.i0 = 0; S.Loff = 0; S.pm_add = 0; S.pn_skip_from = 9; S.pn_skip_by = 3;
                pg8::Gemm g; g.A = WSP(p, bf16_t, WS_HB); g.Bt = W; g.K = 1024;
                EpiIn E; E.P = WSP(p, bf16_t, WS_P); E.qg = p.qg + layer * 64; E.kg = p.kg + layer * 64; E.outk_p = p.out + O_KP + (size_t)layer * CACHE * 768; E.outk_s = p.out + O_KS + (size_t)layer * NS * 768;
                pg8::gemm_phase<EpiIn>(lds, g, S, E);
            }
            {
                pg8::Order S; S.nM = 3; S.nN = 65; S.nwg = 195; S.G = G; S.c = c; S.i0 = c < 780 ? (780 - c + G - 1) / G : 0; S.Loff = 780; S.pm_add = 9; S.pn_skip_from = 1 << 30; S.pn_skip_by = 0;
                pg8::Gemm g; g.A = W; g.Bt = WSP(p, bf16_t, WS_HB); g.K = 1024;
                EpiV E; E.VT1 = WSP(p, bf16_t, WS_VT1); E.VT2 = WSP(p, bf16_t, WS_VT2); E.VT3 = WSP(p, bf16_t, WS_VT3); E.outv_p = p.out + O_VP + (size_t)layer * CACHE * 768; E.outv_s = p.out + O_VS + (size_t)layer * NS * 768;
                pg8::gemm_phase<EpiV>(lds, g, S, E);
            }
        } else if (kind == 2) {
            float gq = 0.f, gk = 0.f;
            for (int i = 0; i < 64; ++i) { gq = fmaxf(gq, fabsf(p.qg[layer * 64 + i])); gk = fmaxf(gk, fabsf(p.kg[layer * 64 + i])); }
            const float Mref = 8.2f * gq * gk;
            for (int item = c; item < 1281; item += G) {
                if (item < 384) attn_item(p, layer, item / 12, item % 12, (float*)shm, Mref * LOG2E);
                else if (item < 896) sgu_item(p, layer, (item - 384) >> 2, (item - 384) & 3, (bf16_t*)shm);
                else if (item < 1280) sattn_item(p, layer, (item - 896) / 12, (item - 896) % 12, (float*)shm, Mref);
                else ssgu_item(p, layer);
            }
        } else {
            LAS unsigned char* lds = (LAS unsigned char*)shm;
            pg8::Order S; S.nM = 65; S.nN = 4; S.nwg = 260; S.G = G; S.c = c; S.i0 = 0; S.Loff = 0; S.pm_add = 0; S.pn_skip_from = 1 << 30; S.pn_skip_by = 0;
            pg8::Gemm g; g.A = WSP(p, bf16_t, WS_G); g.Bt = WSP(p, bf16_t, WS_WOUTT) + (size_t)layer * 1024 * 1024; g.K = 1024;
            EpiOut E;
            if (layer == 0) { E.xin_p = p.x_prompt; E.xin_s = p.x_sample; E.xo_p = WSP(p, float, WS_X1); E.xo_s = WSP(p, float, WS_X1) + (size_t)SEQ * 1024; }
            else { E.xin_p = WSP(p, float, WS_X1); E.xin_s = WSP(p, float, WS_X1) + (size_t)SEQ * 1024; E.xo_p = p.out + O_YP; E.xo_s = p.out + O_YS; }
            pg8::gemm_phase<EpiOut>(lds, g, S, E);
        }
    }
}

#ifndef SINGLE_LAUNCH
#define SINGLE_LAUNCH 1
#endif
extern "C" void kernel_launch(void* const* d_in, const int* in_sizes, int n_in, void* d_out, int out_size, void* d_ws, size_t ws_size, hipStream_t stream) {
    static int grid = 0;
    if (grid == 0) {
        int dev = 0, cus = 0, per_cu = 0;
        hipGetDevice(&dev);
        hipDeviceGetAttribute(&cus, hipDeviceAttributeMultiprocessorCount, dev);
        if (hipFuncSetAttribute((const void*)hymba_fwd, hipFuncAttributeMaxDynamicSharedMemorySize, LDS_BYTES) != hipSuccess) { fprintf(stderr, "hipFuncSetAttribute failed\n"); grid = -1; return; }
        if (hipOccupancyMaxActiveBlocksPerMultiprocessor(&per_cu, (const void*)hymba_fwd, NTHREADS, LDS_BYTES) != hipSuccess || per_cu < 1) { fprintf(stderr, "occupancy query: %d\n", per_cu); per_cu = 1; }
        (void)hipGetLastError();
        if (per_cu > 1) per_cu = 1;
        grid = cus * per_cu;
    }
    if (grid < 0) return;
    Params p{};
    p.x_prompt = (const float*)d_in[0]; p.x_sample = (const float*)d_in[1]; p.cache_k = (const float*)d_in[2]; p.cache_v = (const float*)d_in[3];
    p.norm_g = (const float*)d_in[4]; p.w_in = (const float*)d_in[5]; p.sgu_g = (const float*)d_in[6]; p.w_sp = (const float*)d_in[7]; p.b_sp = (const float*)d_in[8];
    p.qg = (const float*)d_in[9]; p.kg = (const float*)d_in[10]; p.w_out = (const float*)d_in[11];
    p.out = (float*)d_out;
    p.ws = (unsigned char*)d_ws;
    if (ws_size < WS_END) { fprintf(stderr, "workspace too small\n"); return; }
#if SINGLE_LAUNCH
    p.phase_lo = 0; p.phase_hi = 8;
    void* args[] = {&p};
    hipError_t e = hipLaunchCooperativeKernel((const void*)hymba_fwd, dim3(grid), dim3(NTHREADS), args, LDS_BYTES, stream);
    if (e != hipSuccess) fprintf(stderr, "cooperative launch failed: %s (grid %d)\n", hipGetErrorString(e), grid);
#else
    for (int ph = 0; ph < 8; ++ph) { p.phase_lo = ph; p.phase_hi = ph + 1; hipLaunchKernelGGL(hymba_fwd, dim3(grid), dim3(NTHREADS), LDS_BYTES, stream, p); }
#endif
}
```

```cpp
#include <hip/hip_runtime.h>
#include <hip/hip_cooperative_groups.h>
#include <cstdio>
namespace cg = cooperative_groups;

#define LAS __attribute__((address_space(3)))
typedef unsigned short bf16_t;
typedef short bf16x8 __attribute__((ext_vector_type(8)));
typedef float f32x4 __attribute__((ext_vector_type(4)));
typedef float f32x16 __attribute__((ext_vector_type(16)));
typedef unsigned u32x2 __attribute__((ext_vector_type(2)));
typedef unsigned u32x4 __attribute__((ext_vector_type(4)));

constexpr int D_MODEL = 1024, SEQ = 16384, NS = 32, TTOK = SEQ + NS  , MPAD = 16640, PROJ = 3840, CACHE = 2048;
constexpr int NTHREADS = 512;
constexpr int LDS_BYTES = 150 * 1024;
constexpr int LDS_XB = 128 * 1024;
constexpr int LDS_CTL = 150 * 1024 - 16;
constexpr float LOG2E = 1.4426950408889634f;

constexpr size_t O_YP = 0, O_YS = 16777216, O_KP = O_YS + 32768, O_VP = O_KP + 3145728, O_KS = O_VP + 3145728, O_VS = O_KS + 49152, O_SG = O_VS + 49152;

struct Params {
    const float *x_prompt, *x_sample, *cache_k, *cache_v, *norm_g, *w_in, *sgu_g, *w_sp, *b_sp, *qg, *kg, *w_out;
    float* out;
    unsigned char* ws;
    int phase_lo, phase_hi;
};
constexpr size_t al4k(size_t b) { return (b + 4095) & ~(size_t)4095; }
constexpr size_t WS_WINT = 0;
constexpr size_t WS_WOUTT = WS_WINT + al4k((size_t)2 * PROJ * 1024 * 2);
constexpr size_t WS_HB = WS_WOUTT + al4k((size_t)2 * 1024 * 1024 * 2);
constexpr size_t WS_P = WS_HB + al4k((size_t)MPAD * 1024 * 2);
constexpr size_t WS_VT1 = WS_P + al4k((size_t)MPAD * PROJ * 2);
constexpr size_t WS_VT2 = WS_VT1 + al4k((size_t)768 * SEQ * 2);
constexpr size_t WS_VT3 = WS_VT2 + al4k((size_t)768 * SEQ * 2);
constexpr size_t WS_G = WS_VT3 + al4k((size_t)768 * SEQ * 2);
constexpr size_t WS_X1 = WS_G + al4k((size_t)MPAD * 1024 * 2);
constexpr size_t WS_CTL = WS_X1 + al4k((size_t)TTOK * 1024 * 4);
constexpr size_t WS_END = WS_CTL + 4096;
#define WSP(p, T, OFF) ((T*)((p).ws + (OFF)))

__device__ __forceinline__ bf16_t f2bf(float f) { unsigned u = __float_as_uint(f); u += 0x7FFFu + ((u >> 16) & 1u); return (bf16_t)(u >> 16); }
__device__ __forceinline__ unsigned pk2(float lo, float hi) { return (unsigned)f2bf(lo) | ((unsigned)f2bf(hi) << 16); }
__device__ __forceinline__ float bf2f(bf16_t b) { return __uint_as_float(((unsigned)b) << 16); }
__device__ __forceinline__ float bflo(unsigned u) { return __uint_as_float(u << 16); }
__device__ __forceinline__ float bfhi(unsigned u) { return __uint_as_float(u & 0xFFFF0000u); }
__device__ __forceinline__ int opaque_tid() { int t = threadIdx.x; asm volatile("" : "+v"(t)); return t; }
__device__ __forceinline__ float silu(float x) { return x / (1.0f + __expf(-x)); }

namespace pg8 {
constexpr int BM = 256, BK = 64, HALF = 128, HTB = HALF * BK * 2, STAGE_BYTES = 8 * HTB, NXCD = 8, WGM = 8;
__device__ __forceinline__ int lds_byte(int r, int c) { const int st = (r >> 4) * 2 + (c >> 5), rr = r & 15, cc = c & 31, ob = rr * 64 + cc * 2; return st * 1024 + (ob ^ (((ob >> 9) & 1) << 5)); }
__device__ __forceinline__ void stage_rc(int b, int& R, int& C) { const int st = b / 1024, sb = b % 1024, swz = sb ^ (((sb >> 9) & 1) << 5); R = (st >> 1) * 16 + swz / 64; C = (st & 1) * 32 + (swz % 64) / 2; }
struct Unit { int pm, pn; };
struct Gemm { const bf16_t* A; const bf16_t* Bt; int K; };

struct Order {
    int nM, nN, nwg, G, c, i0, Loff, pm_add, pn_skip_from, pn_skip_by;
    __device__ bool next(int i, Unit& u) const {
        const long L = (long)(i + i0) * G + c - Loff; if (L < 0 || L >= nwg) return false;
        int wgid = (int)L; { const int q = nwg / NXCD, r = nwg % NXCD, xcd = wgid % NXCD, off = wgid / NXCD; wgid = (xcd < r ? xcd * (q + 1) : r * (q + 1) + (xcd - r) * q) + off; }
        const int nig = WGM * nN, gid = wgid / nig, fm = gid * WGM, gsz = (nM - fm) < WGM ? (nM - fm) : WGM;
        u.pm = fm + ((wgid % nig) % gsz) + pm_add; int pn = (wgid % nig) / gsz; if (pn >= pn_skip_from) pn += pn_skip_by; u.pn = pn; return true;
    }
};

template <class Epi>
__device__ __forceinline__ void gemm_phase(LAS unsigned char* lds, const Gemm g, const Order& S, const Epi& E) {
    const int tid = opaque_tid(), wid = __builtin_amdgcn_readfirstlane(tid >> 6), lane = tid & 63, wr = wid >> 2, wc = wid & 3, fr = lane & 15, fq = lane >> 4;
    const int K = g.K, nt = K / BK;
    unsigned voffA[2], voffB[2];
#pragma unroll
    for (int i = 0; i < 2; ++i) { int R, C; stage_rc(tid * 16 + i * 8192, R, C); const int Rb = Epi::BPERM ? (64 * (R >> 5) + 16 * ((R >> 2) & 3) + 4 * ((R >> 4) & 1) + (R & 3)) : R;
        voffA[i] = (unsigned)(R * K + C) * 2u; voffB[i] = (unsigned)(Rb * K + C) * 2u; }
    const size_t kstep = (size_t)(BK * 2);
    const size_t hstep = (size_t)HALF * K * 2;
    const size_t hstepB = Epi::BPERM ? (size_t)8 * K * 2 : hstep;
    const size_t tstep = 2 * hstep;
    const unsigned ldsw = (unsigned)wid * 1024u;
    const int aoff = lds_byte(wr * 64 + fr, fq * 8), boff = lds_byte(wc * 32 + fr, fq * 8);
#define PG8_SA(b, h) (((b) * 2 + (h)) * HTB)
#define PG8_SB(b, h) ((4 + (b) * 2 + (h)) * HTB)
#define PG8_STAGE(bufoff, gbase, voff) do { _Pragma("unroll") for (int _i = 0; _i < 2; ++_i) \
        __builtin_amdgcn_global_load_lds((const unsigned*)((const char*)(gbase) + (voff)[_i]), (LAS unsigned*)(lds + (bufoff) + ldsw + _i * 8192), 16, 0, 0); } while (0)
#define PG8_LDA(dst, b, h) do { _Pragma("unroll") for (int m = 0; m < 4; ++m) _Pragma("unroll") for (int k = 0; k < 2; ++k) dst[m][k] = *(const LAS bf16x8*)(lds + PG8_SA(b, h) + aoff + m * 2048 + k * 1024); } while (0)
#define PG8_LDB(dst, b, h) do { _Pragma("unroll") for (int n = 0; n < 2; ++n) _Pragma("unroll") for (int k = 0; k < 2; ++k) dst[n][k] = *(const LAS bf16x8*)(lds + PG8_SB(b, h) + boff + n * 2048 + k * 1024); } while (0)
#define PG8_MMA(ai, bj, At, Bt) do { __builtin_amdgcn_s_setprio(1); _Pragma("unroll") for (int m = 0; m < 4; ++m) _Pragma("unroll") for (int n = 0; n < 2; ++n) _Pragma("unroll") for (int k = 0; k < 2; ++k) \
        acc[ai][bj][m][n] = __builtin_amdgcn_mfma_f32_16x16x32_bf16(Bt[n][k], At[m][k], acc[ai][bj][m][n], 0, 0, 0); __builtin_amdgcn_s_setprio(0); } while (0)
#define PG8_WAIT_V(n) asm volatile("s_waitcnt vmcnt(" #n ")" ::: "memory")
#define PG8_WAIT_L(n) asm volatile("s_waitcnt lgkmcnt(" #n ")" ::: "memory")
#define PG8_BAR __builtin_amdgcn_s_barrier()
#define PG8_SCHED __builtin_amdgcn_sched_barrier(0)
    Unit cur, nxt; int ui = 0;
    if (!S.next(0, cur)) return;
    f32x4 acc[2][2][4][2];
#pragma unroll
    for (int a = 0; a < 2; ++a)
#pragma unroll
        for (int b = 0; b < 2; ++b)
#pragma unroll
            for (int m = 0; m < 4; ++m)
#pragma unroll
                for (int n = 0; n < 2; ++n) acc[a][b][m][n] = (f32x4){0.f, 0.f, 0.f, 0.f};
    bf16x8 At[4][2], B0[2][2], B1[2][2];
    const char* cA = (const char*)g.A + (size_t)cur.pm * tstep; const char* cB = (const char*)g.Bt + (size_t)cur.pn * tstep;
    PG8_STAGE(PG8_SB(0, 0), cB, voffB); PG8_STAGE(PG8_SA(0, 0), cA, voffA); PG8_STAGE(PG8_SB(0, 1), cB + hstepB, voffB); PG8_STAGE(PG8_SA(0, 1), cA + hstep, voffA);
    if (wr == 1) PG8_BAR;
    PG8_WAIT_V(4); PG8_BAR;
    PG8_STAGE(PG8_SB(1, 0), cB + kstep, voffB); PG8_STAGE(PG8_SA(1, 0), cA + kstep, voffA); PG8_STAGE(PG8_SB(1, 1), cB + hstepB + kstep, voffB);
    PG8_WAIT_V(6); PG8_BAR;
    for (;;) {
        const bool has_next = S.next(ui + 1, nxt);
        const char* nA = has_next ? (const char*)g.A + (size_t)nxt.pm * tstep : cA; const char* nB = has_next ? (const char*)g.Bt + (size_t)nxt.pn * tstep : cB;
        for (int t = 0; t < nt; t += 2) {
            const bool last = (t == nt - 2);
            const char* a1 = cA + (size_t)(t + 1) * kstep;
            const char* a2 = last ? nA : cA + (size_t)(t + 2) * kstep; const char* b2 = last ? nB : cB + (size_t)(t + 2) * kstep;
            const char* a3 = a2 + kstep; const char* b3 = b2 + kstep;
            PG8_LDB(B0, 0, 0); PG8_SCHED; PG8_LDA(At, 0, 0); PG8_STAGE(PG8_SA(1, 1), a1 + hstep, voffA);
            PG8_WAIT_L(8); PG8_BAR; PG8_WAIT_L(0); PG8_MMA(0, 0, At, B0); PG8_BAR; PG8_SCHED;
            PG8_LDB(B1, 0, 1); PG8_STAGE(PG8_SB(0, 0), b2, voffB);
            PG8_BAR; PG8_WAIT_L(0); PG8_MMA(0, 1, At, B1); PG8_BAR;
            PG8_LDA(At, 0, 1); PG8_STAGE(PG8_SA(0, 0), a2, voffA);
            PG8_BAR; PG8_WAIT_L(0); PG8_MMA(1, 0, At, B0); PG8_BAR; PG8_SCHED;
            PG8_STAGE(PG8_SB(0, 1), b2 + hstepB, voffB);
            PG8_WAIT_V(6); PG8_BAR; PG8_MMA(1, 1, At, B1); PG8_BAR;
            PG8_LDB(B0, 1, 0); PG8_SCHED; PG8_LDA(At, 1, 0); PG8_STAGE(PG8_SA(0, 1), a2 + hstep, voffA);
            PG8_WAIT_L(8); PG8_BAR; PG8_WAIT_L(0); PG8_MMA(0, 0, At, B0); PG8_BAR; PG8_SCHED;
            PG8_LDB(B1, 1, 1); PG8_STAGE(PG8_SB(1, 0), b3, voffB);
            PG8_BAR; PG8_WAIT_L(0); PG8_MMA(0, 1, At, B1); PG8_BAR;
            PG8_LDA(At, 1, 1); PG8_STAGE(PG8_SA(1, 0), a3, voffA);
            PG8_BAR; PG8_WAIT_L(0); PG8_MMA(1, 0, At, B0); PG8_BAR; PG8_SCHED;
            PG8_STAGE(PG8_SB(1, 1), b3 + hstepB, voffB);
            PG8_WAIT_V(6); PG8_BAR; PG8_MMA(1, 1, At, B1); PG8_BAR;
        }
        E(acc, cur, wr, wc, fr, fq);
        if (!has_next) break;
#pragma unroll
        for (int a = 0; a < 2; ++a)
#pragma unroll
            for (int b = 0; b < 2; ++b)
#pragma unroll
                for (int m = 0; m < 4; ++m)
#pragma unroll
                    for (int n = 0; n < 2; ++n) acc[a][b][m][n] = (f32x4){0.f, 0.f, 0.f, 0.f};
        cur = nxt; cA = nA; cB = nB; ++ui;
    }
    PG8_WAIT_V(0);
    if (wr == 0) PG8_BAR;
    PG8_BAR;
#undef PG8_SA
#undef PG8_SB
#undef PG8_STAGE
#undef PG8_LDA
#undef PG8_LDB
#undef PG8_MMA
#undef PG8_WAIT_V
#undef PG8_WAIT_L
#undef PG8_BAR
#undef PG8_SCHED
}
}
using pg8::Unit;

__device__ __forceinline__ unsigned cvt_pk_bf16(float lo, float hi) { unsigned r; asm("v_cvt_pk_bf16_f32 %0, %1, %2" : "=v"(r) : "v"(lo), "v"(hi)); return r; }

struct EpiIn {
    static constexpr bool BPERM = true;
    bf16_t* P; const float* qg; const float* kg; float* outk_p; float* outk_s;
    __device__ __forceinline__ void operator()(const f32x4 (&acc)[2][2][4][2], const Unit& u, int wr, int wc, int fr, int fq) const {
        const int pn = u.pn;
        const int kind = (pn >= 3 && pn < 6) ? 1 : ((pn >= 6 && pn < 9) ? 2 : 0);
        const int col0 = pn * 256 + wc * 64 + 16 * fq;
        f32x4 gv[2][2];
        const float* gp = kind == 1 ? qg : kg;
#pragma unroll
        for (int bj = 0; bj < 2; ++bj)
#pragma unroll
            for (int n = 0; n < 2; ++n) {
                if (kind) { gv[bj][n] = *(const f32x4*)(gp + 16 * fq + 8 * bj + 4 * n); if (kind == 1) gv[bj][n] = gv[bj][n] * 0.125f; }
                else gv[bj][n] = (f32x4){1.f, 1.f, 1.f, 1.f};
            }
#pragma unroll
        for (int ai = 0; ai < 2; ++ai)
#pragma unroll
            for (int m = 0; m < 4; ++m) {
                const int r = u.pm * 256 + ai * 128 + wr * 64 + m * 16 + fr;
                float rstd = 1.0f;
                if (kind) {
                    float ss = 0.f;
#pragma unroll
                    for (int bj = 0; bj < 2; ++bj)
#pragma unroll
                        for (int n = 0; n < 2; ++n)
#pragma unroll
                            for (int e = 0; e < 4; ++e) ss += acc[ai][bj][m][n][e] * acc[ai][bj][m][n][e];
                    ss += __shfl_xor(ss, 16); ss += __shfl_xor(ss, 32);
                    rstd = rsqrtf(ss * (1.0f / 64.0f) + 1e-6f);
                }
                f32x4 v[2][2];
#pragma unroll
                for (int bj = 0; bj < 2; ++bj)
#pragma unroll
                    for (int n = 0; n < 2; ++n) v[bj][n] = acc[ai][bj][m][n] * gv[bj][n] * rstd;
                if (r < TTOK) {
                    u32x4 o0, o1;
                    o0[0] = cvt_pk_bf16(v[0][0][0], v[0][0][1]); o0[1] = cvt_pk_bf16(v[0][0][2], v[0][0][3]); o0[2] = cvt_pk_bf16(v[0][1][0], v[0][1][1]); o0[3] = cvt_pk_bf16(v[0][1][2], v[0][1][3]);
                    o1[0] = cvt_pk_bf16(v[1][0][0], v[1][0][1]); o1[1] = cvt_pk_bf16(v[1][0][2], v[1][0][3]); o1[2] = cvt_pk_bf16(v[1][1][0], v[1][1][1]); o1[3] = cvt_pk_bf16(v[1][1][2], v[1][1][3]);
                    bf16_t* dst = P + (size_t)r * PROJ + col0;
                    *(u32x4*)dst = o0; *(u32x4*)(dst + 8) = o1;
                    if (kind == 2 && r >= SEQ - CACHE) {
                        float* od = r < SEQ ? outk_p + (size_t)(r - (SEQ - CACHE)) * 768 + (col0 - 1536) : outk_s + (size_t)(r - SEQ) * 768 + (col0 - 1536);
                        *(f32x4*)(od) = v[0][0]; *(f32x4*)(od + 4) = v[0][1]; *(f32x4*)(od + 8) = v[1][0]; *(f32x4*)(od + 12) = v[1][1];
                    }
                }
            }
    }
};
struct EpiV {
    static constexpr bool BPERM = true;
    bf16_t *VT1, *VT2, *VT3; float* outv_p; float* outv_s; LAS unsigned char* xb;
    __device__ __forceinline__ void operator()(const f32x4 (&acc)[2][2][4][2], const Unit& u, int wr, int wc, int fr, int fq) const {
        LAS unsigned char* xw = xb + (wr * 4 + wc) * 2304;
        const int tw = u.pn * 256 + wc * 64;
        const int t0 = tw + 16 * fq;
        const int lane = fr + 16 * fq;
#pragma unroll
        for (int ai = 0; ai < 2; ++ai)
#pragma unroll
            for (int m = 0; m < 4; ++m) {
                const int fbase = u.pm * 256 + ai * 128 + wr * 64 + m * 16 - 2304;
                const int fv = fbase + fr;
                if (tw < SEQ) {
                    u32x4 o0, o1;
                    o0[0] = cvt_pk_bf16(acc[ai][0][m][0][0], acc[ai][0][m][0][1]); o0[1] = cvt_pk_bf16(acc[ai][0][m][0][2], acc[ai][0][m][0][3]);
                    o0[2] = cvt_pk_bf16(acc[ai][0][m][1][0], acc[ai][0][m][1][1]); o0[3] = cvt_pk_bf16(acc[ai][0][m][1][2], acc[ai][0][m][1][3]);
                    o1[0] = cvt_pk_bf16(acc[ai][1][m][0][0], acc[ai][1][m][0][1]); o1[1] = cvt_pk_bf16(acc[ai][1][m][0][2], acc[ai][1][m][0][3]);
                    o1[2] = cvt_pk_bf16(acc[ai][1][m][1][0], acc[ai][1][m][1][1]); o1[3] = cvt_pk_bf16(acc[ai][1][m][1][2], acc[ai][1][m][1][3]);
                    bf16_t* d1 = VT1 + (size_t)fv * SEQ + t0;
                    *(u32x4*)d1 = o0; *(u32x4*)(d1 + 8) = o1;
#pragma unroll
                    for (int e = 0; e < 4; ++e) {
                        u32x2 w2; w2[0] = cvt_pk_bf16(acc[ai][0][m][0][e], acc[ai][0][m][1][e]); w2[1] = cvt_pk_bf16(acc[ai][1][m][0][e], acc[ai][1][m][1][e]);
                        *(u32x2*)(VT2 + (size_t)fv * SEQ + e * 4096 + (t0 >> 2)) = w2;
                    }
                    *(LAS u32x4*)(xw + fr * 144 + fq * 32) = o0; *(LAS u32x4*)(xw + fr * 144 + fq * 32 + 16) = o1;
#pragma unroll
                    for (int k = 0; k < 4; ++k) {
                        const int id = lane + 64 * k, f2 = id & 15, rho = id >> 4;
                        const LAS unsigned short* src = (const LAS unsigned short*)(xw + f2 * 144 + rho * 2);
                        const unsigned a0 = src[0], a1 = src[16], a2 = src[32], a3 = src[48];
                        u32x2 w3; w3[0] = a0 | (a1 << 16); w3[1] = a2 | (a3 << 16);
                        *(u32x2*)(VT3 + (size_t)(fbase + f2) * SEQ + rho * 1024 + (tw >> 4)) = w3;
                    }
                    if (tw >= SEQ - CACHE) {
#pragma unroll
                        for (int bj = 0; bj < 2; ++bj)
#pragma unroll
                            for (int n = 0; n < 2; ++n)
#pragma unroll
                                for (int e = 0; e < 4; ++e) outv_p[(size_t)(t0 + 8 * bj + 4 * n + e - (SEQ - CACHE)) * 768 + fv] = acc[ai][bj][m][n][e];
                    }
                } else if (t0 < TTOK) {
#pragma unroll
                    for (int bj = 0; bj < 2; ++bj)
#pragma unroll
                        for (int n = 0; n < 2; ++n)
#pragma unroll
                            for (int e = 0; e < 4; ++e) outv_s[(size_t)(t0 + 8 * bj + 4 * n + e - SEQ) * 768 + fv] = acc[ai][bj][m][n][e];
                }
            }
    }
};
struct EpiOut {
    static constexpr bool BPERM = true;
    const float* xin; float* xo;
    __device__ __forceinline__ void operator()(const f32x4 (&acc)[2][2][4][2], const Unit& u, int wr, int wc, int fr, int fq) const {
        const int c0 = u.pn * 256 + wc * 64 + 16 * fq;
#pragma unroll
        for (int ai = 0; ai < 2; ++ai)
#pragma unroll
            for (int m = 0; m < 4; ++m) {
                const int r = u.pm * 256 + ai * 128 + wr * 64 + m * 16 + fr;
                const float* xi = xin + (size_t)r * 1024 + c0; float* xop = xo + (size_t)r * 1024 + c0;
                f32x4 x[2][2];
#pragma unroll
                for (int bj = 0; bj < 2; ++bj)
#pragma unroll
                    for (int n = 0; n < 2; ++n) x[bj][n] = *(const f32x4*)(xi + 8 * bj + 4 * n);
#pragma unroll
                for (int bj = 0; bj < 2; ++bj)
#pragma unroll
                    for (int n = 0; n < 2; ++n) *(f32x4*)(xop + 8 * bj + 4 * n) = x[bj][n] + acc[ai][bj][m][n];
            }
    }
};
__device__ void sample_outproj(const Params& p, int layer) {
    const int tid = opaque_tid(), dotid = tid >> 2, sub = tid & 3, row = dotid >> 2;
    const float* xi = layer == 0 ? p.x_sample : WSP(p, float, WS_X1) + (size_t)SEQ * 1024;
    float* xo = layer == 0 ? WSP(p, float, WS_X1) + (size_t)SEQ * 1024 : p.out + O_YS;
    for (int cb = blockIdx.x; cb < 256; cb += gridDim.x) {
        const int col = 4 * cb + (dotid & 3);
        const bf16_t* gp = WSP(p, bf16_t, WS_G) + (size_t)(SEQ + row) * 1024 + sub * 256;
        const bf16_t* wp = WSP(p, bf16_t, WS_WOUTT) + (size_t)layer * 1024 * 1024 + (size_t)col * 1024 + sub * 256;
        float a = 0.f;
#pragma unroll 8
        for (int i = 0; i < 32; ++i) {
            const u32x4 gv = *(const u32x4*)(gp + 8 * i), wv = *(const u32x4*)(wp + 8 * i);
#pragma unroll
            for (int j = 0; j < 4; ++j) a += bflo(gv[j]) * bflo(wv[j]) + bfhi(gv[j]) * bfhi(wv[j]);
        }
        a += __shfl_xor(a, 1); a += __shfl_xor(a, 2);
        if (sub == 0) xo[(size_t)row * 1024 + col] = xi[(size_t)row * 1024 + col] + a;
    }
}
__device__ void transpose_tile(const float* __restrict__ src, bf16_t* __restrict__ dst, int K, int N, int tile_id, float* tile) {
    const int tilesN = N / 64, kb = (tile_id / tilesN) * 64, nb = (tile_id % tilesN) * 64, tid = opaque_tid();
    { const int n = tid & 63, k0 = tid >> 6;
#pragma unroll
      for (int i = 0; i < 8; ++i) { const int k = k0 + 8 * i; tile[k * 65 + n] = src[(size_t)(kb + k) * N + nb + n]; } }
    __syncthreads();
    { const int k = tid & 63, n0 = tid >> 6;
#pragma unroll
      for (int i = 0; i < 8; ++i) { const int n = n0 + 8 * i; dst[(size_t)(nb + n) * K + kb + k] = f2bf(tile[k * 65 + n]); } }
    __syncthreads();
}

__device__ void rmsnorm_rows(const Params& p, int layer) {
    const int tid = opaque_tid(), lane = tid & 63, wg = blockIdx.x * 8 + (tid >> 6), nw = gridDim.x * 8;
    const float* g = p.norm_g + layer * 1024;
    for (int row = wg; row < TTOK; row += nw) {
        const float* src = layer == 0 ? (row < SEQ ? p.x_prompt + (size_t)row * 1024 : p.x_sample + (size_t)(row - SEQ) * 1024) : WSP(p, float, WS_X1) + (size_t)row * 1024;
        f32x4 v[4]; float ss = 0.f;
#pragma unroll
        for (int i = 0; i < 4; ++i) { v[i] = *(const f32x4*)(src + i * 256 + lane * 4); ss += v[i][0] * v[i][0] + v[i][1] * v[i][1] + v[i][2] * v[i][2] + v[i][3] * v[i][3]; }
#pragma unroll
        for (int o = 32; o >= 1; o >>= 1) ss += __shfl_xor(ss, o);
        const float rstd = rsqrtf(ss * (1.0f / 1024.0f) + 1e-6f);
#pragma unroll
        for (int i = 0; i < 4; ++i) { const f32x4 gv = *(const f32x4*)(g + i * 256 + lane * 4); const f32x4 y = v[i] * rstd * gv;
            u32x2 o; o[0] = pk2(y[0], y[1]); o[1] = pk2(y[2], y[3]); *(u32x2*)(WSP(p, bf16_t, WS_HB) + (size_t)row * 1024 + i * 256 + lane * 4) = o; }
    }
}

struct KVf { bf16x8 k[4]; u32x2 vlo[2][2], vhi[2][2]; };
__device__ __forceinline__ void load_kv(KVf& f, const bf16_t* __restrict__ kbase  , const bf16_t* __restrict__ vrow, int qbase, int dil, int vidx0, int kk0, int c, int hh) {
    int kpos = qbase + dil * (kk0 + c); kpos = kpos < 0 ? 0 : kpos;
    const bf16_t* kp = kbase + (size_t)kpos * PROJ;
#pragma unroll
    for (int s = 0; s < 4; ++s) f.k[s] = *(const bf16x8*)(kp + 16 * s);
#pragma unroll
    for (int s2 = 0; s2 < 2; ++s2) {
        int i0 = vidx0 + kk0 + 16 * s2 + 4 * hh; int i1 = i0 + 8; i0 = i0 < 0 ? 0 : i0; i1 = i1 < 0 ? 0 : i1;
#pragma unroll
        for (int mt = 0; mt < 2; ++mt) { f.vlo[mt][s2] = *(const u32x2*)(vrow + (size_t)(32 * mt) * SEQ + i0); f.vhi[mt][s2] = *(const u32x2*)(vrow + (size_t)(32 * mt) * SEQ + i1); }
    }
}
template <bool MASK>
__device__ __forceinline__ void attn_tile(const KVf& f, const bf16x8 (&qf)[4], f32x16& O0, f32x16& O1, float& den, float dsl, float base, int kk0, int vidx0, int c, int hh) {
    f32x16 S;
#pragma unroll
    for (int r = 0; r < 16; ++r) S[r] = 0.f;
#pragma unroll
    for (int s = 0; s < 4; ++s) S = __builtin_amdgcn_mfma_f32_32x32x16_bf16(f.k[s], qf[s], S, 0, 0, 0);
#pragma unroll
    for (int r = 0; r < 16; ++r) {
        const int rowc = (r & 3) + 8 * (r >> 2);
        float pv = __builtin_amdgcn_exp2f(fmaf(S[r], LOG2E, fmaf(dsl, (float)rowc, base)));
        if (MASK) { const int kk = kk0 + rowc + 4 * hh; const int dd = c - kk; const bool valid = (dd >= 0) && (dd <= 128) && (vidx0 + kk >= 0); pv = valid ? pv : 0.f; }
        den += pv; S[r] = pv;
    }
#pragma unroll
    for (int s2 = 0; s2 < 2; ++s2) {
        u32x4 pw;
#pragma unroll
        for (int j = 0; j < 4; ++j) pw[j] = cvt_pk_bf16(S[8 * s2 + 2 * j], S[8 * s2 + 2 * j + 1]);
        const bf16x8 pf = __builtin_bit_cast(bf16x8, pw);
        { u32x4 vw; vw[0] = f.vlo[0][s2][0]; vw[1] = f.vlo[0][s2][1]; vw[2] = f.vhi[0][s2][0]; vw[3] = f.vhi[0][s2][1];
          O0 = __builtin_amdgcn_mfma_f32_32x32x16_bf16(__builtin_bit_cast(bf16x8, vw), pf, O0, 0, 0, 0); }
        { u32x4 vw; vw[0] = f.vlo[1][s2][0]; vw[1] = f.vlo[1][s2][1]; vw[2] = f.vhi[1][s2][0]; vw[3] = f.vhi[1][s2][1];
          O1 = __builtin_amdgcn_mfma_f32_32x32x16_bf16(__builtin_bit_cast(bf16x8, vw), pf, O1, 0, 0, 0); }
    }
}

__device__ void attn_item(const Params& p, int layer, int sb, int h, float* accL, float Mref2) {
    const int tid = opaque_tid(), w = tid >> 6, lane = tid & 63, c = lane & 31, hh = lane >> 5;
    const int T0 = sb * 512;
    const float sl2 = exp2f(-8.0f * (float)(h + 1) / 12.0f) * LOG2E;
    const bf16_t* __restrict__ P = WSP(p, bf16_t, WS_P);
    const bf16_t* __restrict__ kbase = P + 1536 + h * 64 + 8 * hh;
#pragma unroll 1
    for (int pat = 0; pat < 3; ++pat) {
        const int ldil = 2 * pat, dil = 1 << ldil;
        const bf16_t* __restrict__ VT = pat == 0 ? WSP(p, bf16_t, WS_VT1) : (pat == 1 ? WSP(p, bf16_t, WS_VT2) : WSP(p, bf16_t, WS_VT3));
        const float dsl = sl2 * (float)dil;
#pragma unroll 1
        for (int tt = 0; tt < 2; ++tt) {
            const int tl = w + 8 * tt;
            const int qb = pat == 0 ? 32 * tl : (pat == 1 ? 128 * (tl >> 2) + (tl & 3) : tl);
            const int qbase = T0 + qb;
            const int vidx0 = qbase >> ldil;
            const int res = qbase & (dil - 1);
            const bf16_t* __restrict__ vrow = VT + (size_t)(h * 64 + c) * SEQ + (size_t)res * (SEQ >> ldil);
            KVf fa, fb;
            load_kv(fa, kbase, vrow, qbase, dil, vidx0, -128, c, hh);
            bf16x8 qf[4];
            { const bf16_t* qp = P + (size_t)(qbase + dil * c) * PROJ + 768 + h * 64 + 8 * hh;
#pragma unroll
              for (int s = 0; s < 4; ++s) qf[s] = *(const bf16x8*)(qp + 16 * s); }
            f32x16 O0, O1;
#pragma unroll
            for (int r = 0; r < 16; ++r) { O0[r] = 0.f; O1[r] = 0.f; }
            float den = 0.f;
            const bool seqstart = vidx0 < 128;
            const float b0 = -dsl * (float)(c - 4 * hh) - Mref2;
#pragma unroll 1
            for (int kt = 0; kt < 5; ++kt) {
                const int kk0 = -128 + 32 * kt;
                if (kt < 4) load_kv(fb, kbase, vrow, qbase, dil, vidx0, kk0 + 32, c, hh);
                const float base = b0 + dsl * (float)kk0;
                if (kt == 0 || kt == 4 || seqstart) attn_tile<true>(fa, qf, O0, O1, den, dsl, base, kk0, vidx0, c, hh);
                else attn_tile<false>(fa, qf, O0, O1, den, dsl, base, kk0, vidx0, c, hh);
                fa = fb;
            }
            den += __shfl_xor(den, 32);
            float* arow = accL + (qb + dil * c) * 65;
            if (pat == 0) {
#pragma unroll
                for (int r = 0; r < 16; ++r) { const int d = (r & 3) + 8 * (r >> 2) + 4 * hh; arow[d] = O0[r]; arow[32 + d] = O1[r]; }
                if (hh == 0) arow[64] = den;
            } else {
#pragma unroll
                for (int r = 0; r < 16; ++r) { const int d = (r & 3) + 8 * (r >> 2) + 4 * hh; arow[d] += O0[r]; arow[32 + d] += O1[r]; }
                if (hh == 0) arow[64] += den;
            }
        }
        __syncthreads();
    }
    bf16_t* __restrict__ Gp = WSP(p, bf16_t, WS_G);
#pragma unroll 1
    for (int it = 0; it < 4; ++it) {
        unsigned zb[8];
#pragma unroll
        for (int j = 0; j < 8; ++j) { const int idx = tid + NTHREADS * (it * 8 + j); const int ql = idx >> 5, d2 = (idx & 31) * 2;
            zb[j] = *(const unsigned*)(P + (size_t)(T0 + ql) * PROJ + 3072 + h * 64 + d2); }
#pragma unroll
        for (int j = 0; j < 8; ++j) { const int idx = tid + NTHREADS * (it * 8 + j); const int ql = idx >> 5, d2 = (idx & 31) * 2;
            const float inv = 1.0f / accL[ql * 65 + 64];
            const float o0 = accL[ql * 65 + d2] * inv * silu(bflo(zb[j])), o1 = accL[ql * 65 + d2 + 1] * inv * silu(bfhi(zb[j]));
            *(unsigned*)(Gp + (size_t)(T0 + ql) * 1024 + 256 + h * 64 + d2) = cvt_pk_bf16(o0, o1); }
    }
    __syncthreads();
}

__device__ void sgu_item(const Params& p, int layer, int ch, int g, bf16_t* vnT  ) {
    const int tid = opaque_tid(), w = tid >> 6, lane = tid & 63, c = lane & 31, hh = lane >> 5;
    const int R0 = ch * 128;
    const bf16_t* __restrict__ P = WSP(p, bf16_t, WS_P);
    const float* sg = p.sgu_g + layer * 256;
    const int tt = w >> 1, dt = w & 1;
    const int t = 32 * tt + c;
    const float* wrow = p.w_sp + ((size_t)(layer * 4 + g) * 128 + t) * 128 + 8 * hh;
    u32x2 vv[16];
#pragma unroll
    for (int rr = 0; rr < 16; ++rr) vv[rr] = *(const u32x2*)(P + (size_t)(R0 + w * 16 + rr) * PROJ + 256 + lane * 4);
    f32x4 w0[8], w1[8];
#pragma unroll
    for (int ks = 0; ks < 8; ++ks) { if (ks <= 2 * tt + 1) { w0[ks] = *(const f32x4*)(wrow + 16 * ks); w1[ks] = *(const f32x4*)(wrow + 16 * ks + 4); } else { w0[ks] = (f32x4){0.f, 0.f, 0.f, 0.f}; w1[ks] = w0[ks]; } }
    const f32x4 gv = *(const f32x4*)(sg + g * 64 + (lane & 15) * 4);
#pragma unroll
    for (int rr = 0; rr < 16; ++rr) {
        const int row = w * 16 + rr;
        const float f0 = bflo(vv[rr][0]), f1 = bfhi(vv[rr][0]), f2 = bflo(vv[rr][1]), f3 = bfhi(vv[rr][1]);
        float ss = f0 * f0 + f1 * f1 + f2 * f2 + f3 * f3;
#pragma unroll
        for (int o = 32; o >= 1; o >>= 1) ss += __shfl_xor(ss, o);
        const float rstd = rsqrtf(ss * (1.0f / 256.0f) + 1e-6f);
        if ((lane >> 4) == g) {
            const int dl = (lane & 15) * 4;
            vnT[(dl + 0) * 136 + row] = f2bf(f0 * rstd * gv[0]); vnT[(dl + 1) * 136 + row] = f2bf(f1 * rstd * gv[1]);
            vnT[(dl + 2) * 136 + row] = f2bf(f2 * rstd * gv[2]); vnT[(dl + 3) * 136 + row] = f2bf(f3 * rstd * gv[3]);
        }
    }
    const float* bsp = p.b_sp + (size_t)(layer * 4 + g) * 128;
    const int colA = g * 64 + 32 * dt + c;
    bf16_t uav[16], zav[16]; float bv[16];
#pragma unroll
    for (int r = 0; r < 16; ++r) { const int tr = 32 * tt + (r & 3) + 8 * (r >> 2) + 4 * hh; const size_t row = (size_t)(R0 + tr);
        uav[r] = P[row * PROJ + colA]; zav[r] = P[row * PROJ + 512 + colA]; bv[r] = bsp[tr]; }
    __syncthreads();
    f32x16 acc;
#pragma unroll
    for (int r = 0; r < 16; ++r) acc[r] = 0.f;
#pragma unroll
    for (int ks = 0; ks < 8; ++ks) {
        if (ks <= 2 * tt + 1) {
            const int s0 = 16 * ks + 8 * hh;
            u32x4 aw;
            aw[0] = cvt_pk_bf16(s0 + 0 <= t ? w0[ks][0] : 0.f, s0 + 1 <= t ? w0[ks][1] : 0.f); aw[1] = cvt_pk_bf16(s0 + 2 <= t ? w0[ks][2] : 0.f, s0 + 3 <= t ? w0[ks][3] : 0.f);
            aw[2] = cvt_pk_bf16(s0 + 4 <= t ? w1[ks][0] : 0.f, s0 + 5 <= t ? w1[ks][1] : 0.f); aw[3] = cvt_pk_bf16(s0 + 6 <= t ? w1[ks][2] : 0.f, s0 + 7 <= t ? w1[ks][3] : 0.f);
            const bf16x8 bfrag = *(const bf16x8*)(vnT + (32 * dt + c) * 136 + s0);
            acc = __builtin_amdgcn_mfma_f32_32x32x16_bf16(__builtin_bit_cast(bf16x8, aw), bfrag, acc, 0, 0, 0);
        }
    }
    bf16_t* __restrict__ Gp = WSP(p, bf16_t, WS_G);
#pragma unroll
    for (int r = 0; r < 16; ++r) {
        const int tr = 32 * tt + (r & 3) + 8 * (r >> 2) + 4 * hh;
        Gp[(size_t)(R0 + tr) * 1024 + colA] = f2bf(bf2f(uav[r]) * (acc[r] + bv[r]) * silu(bf2f(zav[r])));
    }
    __syncthreads();
}

__device__ void sattn_item(const Params& p, int layer, int b, int h, float* part  , float Mref) {
    const int tid = opaque_tid();
    const float slope = exp2f(-8.0f * (float)(h + 1) / 12.0f);
    const size_t tok = (size_t)(SEQ + b);
    const bf16_t* __restrict__ P = WSP(p, bf16_t, WS_P);
    const float* ck = p.cache_k + ((size_t)(layer * NS + b) * CACHE) * 768 + h * 64;
    const float* cv = p.cache_v + ((size_t)(layer * NS + b) * CACHE) * 768 + h * 64;
    const float* nk = p.out + O_KS + ((size_t)(layer * NS + b)) * 768 + h * 64;
    const float* nv = p.out + O_VS + ((size_t)(layer * NS + b)) * 768 + h * 64;
    const int sub = tid & 15, grp = tid >> 4;
    f32x4 k4[13], v4[13];
#pragma unroll
    for (int it = 0; it < 13; ++it) {
        const int e = it * 32 + grp; const int ee = e < 387 ? e : 0; const int pat = ee >= 258 ? 2 : (ee >= 129 ? 1 : 0); const int j = ee - pat * 129; const int dist = j << (2 * pat);
        const float* kr = dist == 0 ? nk : ck + (size_t)(CACHE - dist) * 768;
        const float* vr = dist == 0 ? nv : cv + (size_t)(CACHE - dist) * 768;
        k4[it] = *(const f32x4*)(kr + sub * 4); v4[it] = *(const f32x4*)(vr + sub * 4);
    }
    f32x4 q4;
    { const u32x2 qv = *(const u32x2*)(P + tok * PROJ + 768 + h * 64 + sub * 4); q4[0] = bflo(qv[0]); q4[1] = bfhi(qv[0]); q4[2] = bflo(qv[1]); q4[3] = bfhi(qv[1]); }
    const float zbv = tid < 64 ? bf2f(P[tok * PROJ + 3072 + h * 64 + tid]) : 0.f;
    f32x4 acc = (f32x4){0.f, 0.f, 0.f, 0.f}; float den = 0.f;
#pragma unroll
    for (int it = 0; it < 13; ++it) {
        const int e = it * 32 + grp; const bool act = e < 387; const int ee = act ? e : 0; const int pat = ee >= 258 ? 2 : (ee >= 129 ? 1 : 0); const int j = ee - pat * 129; const int dist = j << (2 * pat);
        float d = q4[0] * k4[it][0] + q4[1] * k4[it][1] + q4[2] * k4[it][2] + q4[3] * k4[it][3];
        d += __shfl_xor(d, 1); d += __shfl_xor(d, 2); d += __shfl_xor(d, 4); d += __shfl_xor(d, 8);
        const float pe = act ? __expf(d - slope * (float)dist - Mref) : 0.f;
        acc += v4[it] * pe; den += pe;
    }
    *(f32x4*)(part + grp * 68 + sub * 4) = acc; if (sub == 0) part[grp * 68 + 64] = den;
    __syncthreads();
    if (tid < 64) {
        float num = 0.f, dn = 0.f;
#pragma unroll
        for (int k = 0; k < 32; ++k) { num += part[k * 68 + tid]; dn += part[k * 68 + 64]; }
        WSP(p, bf16_t, WS_G)[tok * 1024 + 256 + h * 64 + tid] = f2bf(num / dn * silu(zbv));
    }
    __syncthreads();
}

__device__ void ssgu_item(const Params& p, int layer) {
    const int tid = opaque_tid(), w = tid >> 6, lane = tid & 63;
    const float* sg = p.sgu_g + layer * 256;
    const bf16_t* __restrict__ P = WSP(p, bf16_t, WS_P);
    for (int rr = 0; rr < 4; ++rr) {
        const int b = w * 4 + rr; const size_t tok = (size_t)(SEQ + b);
        const u32x2 v = *(const u32x2*)(P + tok * PROJ + 256 + lane * 4);
        const u32x2 uav = *(const u32x2*)(P + tok * PROJ + lane * 4), zav = *(const u32x2*)(P + tok * PROJ + 512 + lane * 4);
        float f[4] = {bflo(v[0]), bfhi(v[0]), bflo(v[1]), bfhi(v[1])};
        float ss = f[0] * f[0] + f[1] * f[1] + f[2] * f[2] + f[3] * f[3];
#pragma unroll
        for (int o = 32; o >= 1; o >>= 1) ss += __shfl_xor(ss, o);
        const float rstd = rsqrtf(ss * (1.0f / 256.0f) + 1e-6f);
        const int g = lane >> 4;
        const float w00 = p.w_sp[(size_t)(layer * 4 + g) * 128 * 128], b0 = p.b_sp[(size_t)(layer * 4 + g) * 128];
        const float ua[4] = {bflo(uav[0]), bfhi(uav[0]), bflo(uav[1]), bfhi(uav[1])}, za[4] = {bflo(zav[0]), bfhi(zav[0]), bflo(zav[1]), bfhi(zav[1])};
        const f32x4 gv = *(const f32x4*)(sg + lane * 4);
        f32x4 vn; float o[4];
#pragma unroll
        for (int e = 0; e < 4; ++e) { vn[e] = f[e] * rstd * gv[e]; o[e] = ua[e] * (w00 * vn[e] + b0) * silu(za[e]); }
        *(f32x4*)(p.out + O_SG + ((size_t)(layer * NS + b)) * 256 + lane * 4) = vn;
        u32x2 go; go[0] = pk2(o[0], o[1]); go[1] = pk2(o[2], o[3]);
        *(u32x2*)(WSP(p, bf16_t, WS_G) + tok * 1024 + lane * 4) = go;
    }
    __syncthreads();
}

__global__ void __launch_bounds__(NTHREADS, 2) hymba_fwd(Params p) {
    extern __shared__ __attribute__((aligned(16))) unsigned char shm[];
    cg::grid_group grid = cg::this_grid();
    const int G = gridDim.x, c = blockIdx.x;
    for (int ph = p.phase_lo; ph < p.phase_hi; ++ph) {
        if (ph > p.phase_lo) grid.sync();
        const int layer = ph >> 2, kind = ph & 3;
#ifdef DUP_KIND
        for (int rep = 0; rep < ((kind == DUP_KIND) ? 2 : 1); ++rep) {
            if (rep) __syncthreads();
#endif
        if (kind == 0) {
            if (layer == 0) {
                if (c == 0 && threadIdx.x < 8) WSP(p, int, WS_CTL)[threadIdx.x] = 0;
                float* tile = (float*)shm;
                for (int t = c; t < 2432; t += G) {
                    int tt = t; const int l = tt / 1216; tt -= l * 1216;
                    if (tt < 960) transpose_tile(p.w_in + (size_t)l * 1024 * PROJ, WSP(p, bf16_t, WS_WINT) + (size_t)l * PROJ * 1024, 1024, PROJ, tt, tile);
                    else transpose_tile(p.w_out + (size_t)l * 1024 * 1024, WSP(p, bf16_t, WS_WOUTT) + (size_t)l * 1024 * 1024, 1024, 1024, tt - 960, tile);
                }
            }
            rmsnorm_rows(p, layer);
        } else if (kind == 1) {
            LAS unsigned char* lds = (LAS unsigned char*)shm;
            const bf16_t* W = WSP(p, bf16_t, WS_WINT) + (size_t)layer * PROJ * 1024;
            {
                pg8::Order S; S.nM = 65; S.nN = 12; S.nwg = 780; S.G = G; S.c = c; S.i0 = 0; S.Loff = 0; S.pm_add = 0; S.pn_skip_from = 9; S.pn_skip_by = 3;
                pg8::Gemm g; g.A = WSP(p, bf16_t, WS_HB); g.Bt = W; g.K = 1024;
                EpiIn E; E.P = WSP(p, bf16_t, WS_P); E.qg = p.qg + layer * 64; E.kg = p.kg + layer * 64; E.outk_p = p.out + O_KP + (size_t)layer * CACHE * 768; E.outk_s = p.out + O_KS + (size_t)layer * NS * 768;
                pg8::gemm_phase<EpiIn>(lds, g, S, E);
            }
            {
                pg8::Order S; S.nM = 3; S.nN = 65; S.nwg = 195; S.G = G; S.c = c; S.i0 = c < 780 ? (780 - c + G - 1) / G : 0; S.Loff = 780; S.pm_add = 9; S.pn_skip_from = 1 << 30; S.pn_skip_by = 0;
                pg8::Gemm g; g.A = W; g.Bt = WSP(p, bf16_t, WS_HB); g.K = 1024;
                EpiV E; E.VT1 = WSP(p, bf16_t, WS_VT1); E.VT2 = WSP(p, bf16_t, WS_VT2); E.VT3 = WSP(p, bf16_t, WS_VT3); E.outv_p = p.out + O_VP + (size_t)layer * CACHE * 768; E.outv_s = p.out + O_VS + (size_t)layer * NS * 768;
                E.xb = lds + LDS_XB;
                pg8::gemm_phase<EpiV>(lds, g, S, E);
            }
        } else if (kind == 2) {
            float gq = 0.f, gk = 0.f;
            for (int i = 0; i < 64; ++i) { gq = fmaxf(gq, fabsf(p.qg[layer * 64 + i])); gk = fmaxf(gk, fabsf(p.kg[layer * 64 + i])); }
            const float Mref = 8.2f * gq * gk;
            int* ctr = WSP(p, int, WS_CTL) + layer
#ifdef DUP_KIND
                + 2 * rep
#endif
                ;
            volatile int* slot = (volatile int*)(shm + LDS_CTL);
            if (threadIdx.x == 0) *slot = atomicAdd(ctr, 1);
            __syncthreads();
            int item = *slot;
            while (item < 1281) {
                __syncthreads();
                int nxt = 0;
                if (threadIdx.x == 0) nxt = atomicAdd(ctr, 1);
                if (item < 384) attn_item(p, layer, item / 12, item % 12, (float*)shm, Mref * LOG2E);
                else if (item < 768) sattn_item(p, layer, (item - 384) / 12, (item - 384) % 12, (float*)shm, Mref);
                else if (item < 1280) sgu_item(p, layer, (item - 768) >> 2, (item - 768) & 3, (bf16_t*)shm);
                else ssgu_item(p, layer);
                if (threadIdx.x == 0) *slot = nxt;
                __syncthreads();
                item = *slot;
            }
        } else {
            LAS unsigned char* lds = (LAS unsigned char*)shm;
            pg8::Order S; S.nM = 64; S.nN = 4; S.nwg = 256; S.G = G; S.c = c; S.i0 = 0; S.Loff = 0; S.pm_add = 0; S.pn_skip_from = 1 << 30; S.pn_skip_by = 0;
            pg8::Gemm g; g.A = WSP(p, bf16_t, WS_G); g.Bt = WSP(p, bf16_t, WS_WOUTT) + (size_t)layer * 1024 * 1024; g.K = 1024;
            EpiOut E;
            if (layer == 0) { E.xin = p.x_prompt; E.xo = WSP(p, float, WS_X1); }
            else { E.xin = WSP(p, float, WS_X1); E.xo = p.out + O_YP; }
            pg8::gemm_phase<EpiOut>(lds, g, S, E);
            sample_outproj(p, layer);
        }
#ifdef DUP_KIND
        }
#endif
    }
}

#ifndef SINGLE_LAUNCH
#define SINGLE_LAUNCH 1
#endif
extern "C" void kernel_launch(void* const* d_in, const int* in_sizes, int n_in, void* d_out, int out_size, void* d_ws, size_t ws_size, hipStream_t stream) {
    static int grid = 0;
    if (grid == 0) {
        int dev = 0, cus = 0, per_cu = 0;
        hipGetDevice(&dev);
        hipDeviceGetAttribute(&cus, hipDeviceAttributeMultiprocessorCount, dev);
        if (hipFuncSetAttribute((const void*)hymba_fwd, hipFuncAttributeMaxDynamicSharedMemorySize, LDS_BYTES) != hipSuccess) { fprintf(stderr, "hipFuncSetAttribute failed\n"); grid = -1; return; }
        if (hipOccupancyMaxActiveBlocksPerMultiprocessor(&per_cu, (const void*)hymba_fwd, NTHREADS, LDS_BYTES) != hipSuccess || per_cu < 1) { fprintf(stderr, "occupancy query: %d\n", per_cu); per_cu = 1; }
        (void)hipGetLastError();
        if (per_cu > 1) per_cu = 1;
        grid = cus * per_cu;
    }
    if (grid < 0) return;
    Params p{};
    p.x_prompt = (const float*)d_in[0]; p.x_sample = (const float*)d_in[1]; p.cache_k = (const float*)d_in[2]; p.cache_v = (const float*)d_in[3];
    p.norm_g = (const float*)d_in[4]; p.w_in = (const float*)d_in[5]; p.sgu_g = (const float*)d_in[6]; p.w_sp = (const float*)d_in[7]; p.b_sp = (const float*)d_in[8];
    p.qg = (const float*)d_in[9]; p.kg = (const float*)d_in[10]; p.w_out = (const float*)d_in[11];
    p.out = (float*)d_out;
    p.ws = (unsigned char*)d_ws;
    if (ws_size < WS_END) { fprintf(stderr, "workspace too small\n"); return; }
#if SINGLE_LAUNCH
    p.phase_lo = 0; p.phase_hi = 8;
    void* args[] = {&p};
    hipError_t e = hipLaunchCooperativeKernel((const void*)hymba_fwd, dim3(grid), dim3(NTHREADS), args, LDS_BYTES, stream);
    if (e != hipSuccess) fprintf(stderr, "cooperative launch failed: %s (grid %d)\n", hipGetErrorString(e), grid);
#else
    for (int ph = 0; ph < 8; ++ph) { p.phase_lo = ph; p.phase_hi = ph + 1; hipLaunchKernelGGL(hymba_fwd, dim3(grid), dim3(NTHREADS), LDS_BYTES, stream, p); }
#endif
}
```

```cpp
#include <hip/hip_runtime.h>
#include <hip/hip_cooperative_groups.h>
#include <cstdio>
namespace cg = cooperative_groups;

#define LAS __attribute__((address_space(3)))
typedef unsigned short bf16_t;
typedef short bf16x8 __attribute__((ext_vector_type(8)));
typedef float f32x4 __attribute__((ext_vector_type(4)));
typedef float f32x16 __attribute__((ext_vector_type(16)));
typedef unsigned u32x2 __attribute__((ext_vector_type(2)));
typedef unsigned u32x4 __attribute__((ext_vector_type(4)));

constexpr int D_MODEL = 1024, SEQ = 16384, NS = 32, TTOK = SEQ + NS  , MPAD = 16640, PROJ = 3840, CACHE = 2048;
constexpr int NTHREADS = 512;
constexpr int LDS_BYTES = 150 * 1024;
constexpr int LDS_XB = 128 * 1024;
constexpr int LDS_CTL = 150 * 1024 - 16;
constexpr float LOG2E = 1.4426950408889634f;

constexpr size_t O_YP = 0, O_YS = 16777216, O_KP = O_YS + 32768, O_VP = O_KP + 3145728, O_KS = O_VP + 3145728, O_VS = O_KS + 49152, O_SG = O_VS + 49152;

struct Params {
    const float *x_prompt, *x_sample, *cache_k, *cache_v, *norm_g, *w_in, *sgu_g, *w_sp, *b_sp, *qg, *kg, *w_out;
    float* out;
    unsigned char* ws;
    int phase_lo, phase_hi;
};
constexpr size_t al4k(size_t b) { return (b + 4095) & ~(size_t)4095; }
constexpr size_t WS_WINT = 0;
constexpr size_t WS_WOUTT = WS_WINT + al4k((size_t)2 * PROJ * 1024 * 2);
constexpr size_t WS_HB = WS_WOUTT + al4k((size_t)2 * 1024 * 1024 * 2);
constexpr size_t WS_P = WS_HB + al4k((size_t)MPAD * 1024 * 2);
constexpr size_t WS_VT1 = WS_P + al4k((size_t)MPAD * PROJ * 2);
constexpr size_t WS_VT2 = WS_VT1 + al4k((size_t)768 * SEQ * 2);
constexpr size_t WS_VT3 = WS_VT2 + al4k((size_t)768 * SEQ * 2);
constexpr size_t WS_G = WS_VT3 + al4k((size_t)768 * SEQ * 2);
constexpr size_t WS_X1 = WS_G + al4k((size_t)MPAD * 1024 * 2);
constexpr size_t WS_CTL = WS_X1 + al4k((size_t)TTOK * 1024 * 4);
constexpr size_t WS_END = WS_CTL + 4096;
#define WSP(p, T, OFF) ((T*)((p).ws + (OFF)))

__device__ __forceinline__ bf16_t f2bf(float f) { unsigned u = __float_as_uint(f); u += 0x7FFFu + ((u >> 16) & 1u); return (bf16_t)(u >> 16); }
__device__ __forceinline__ unsigned pk2(float lo, float hi) { return (unsigned)f2bf(lo) | ((unsigned)f2bf(hi) << 16); }
__device__ __forceinline__ float bf2f(bf16_t b) { return __uint_as_float(((unsigned)b) << 16); }
__device__ __forceinline__ float bflo(unsigned u) { return __uint_as_float(u << 16); }
__device__ __forceinline__ float bfhi(unsigned u) { return __uint_as_float(u & 0xFFFF0000u); }
__device__ __forceinline__ int opaque_tid() { int t = threadIdx.x; asm volatile("" : "+v"(t)); return t; }
__device__ __forceinline__ float silu(float x) { return x / (1.0f + __expf(-x)); }

namespace pg8 {
constexpr int BM = 256, BK = 64, HALF = 128, HTB = HALF * BK * 2, STAGE_BYTES = 8 * HTB, NXCD = 8, WGM = 8;
__device__ __forceinline__ int lds_byte(int r, int c) { const int st = (r >> 4) * 2 + (c >> 5), rr = r & 15, cc = c & 31, ob = rr * 64 + cc * 2; return st * 1024 + (ob ^ (((ob >> 9) & 1) << 5)); }
__device__ __forceinline__ void stage_rc(int b, int& R, int& C) { const int st = b / 1024, sb = b % 1024, swz = sb ^ (((sb >> 9) & 1) << 5); R = (st >> 1) * 16 + swz / 64; C = (st & 1) * 32 + (swz % 64) / 2; }
struct Unit { int pm, pn; };
struct Gemm { const bf16_t* A; const bf16_t* Bt; int K; };

struct Order {
    int nM, nN, nwg, G, c, i0, Loff, pm_add, pn_skip_from, pn_skip_by;
    __device__ bool next(int i, Unit& u) const {
        const long L = (long)(i + i0) * G + c - Loff; if (L < 0 || L >= nwg) return false;
        int wgid = (int)L; { const int q = nwg / NXCD, r = nwg % NXCD, xcd = wgid % NXCD, off = wgid / NXCD; wgid = (xcd < r ? xcd * (q + 1) : r * (q + 1) + (xcd - r) * q) + off; }
        const int nig = WGM * nN, gid = wgid / nig, fm = gid * WGM, gsz = (nM - fm) < WGM ? (nM - fm) : WGM;
        u.pm = fm + ((wgid % nig) % gsz) + pm_add; int pn = (wgid % nig) / gsz; if (pn >= pn_skip_from) pn += pn_skip_by; u.pn = pn; return true;
    }
};

template <class Epi>
__device__ __forceinline__ void gemm_phase(LAS unsigned char* lds, const Gemm g, const Order& S, const Epi& E) {
    const int tid = opaque_tid(), wid = __builtin_amdgcn_readfirstlane(tid >> 6), lane = tid & 63, wr = wid >> 2, wc = wid & 3, fr = lane & 15, fq = lane >> 4;
    const int K = g.K, nt = K / BK;
    unsigned voffA[2], voffB[2];
#pragma unroll
    for (int i = 0; i < 2; ++i) { int R, C; stage_rc(tid * 16 + i * 8192, R, C); const int Rb = Epi::BPERM ? (64 * (R >> 5) + 16 * ((R >> 2) & 3) + 4 * ((R >> 4) & 1) + (R & 3)) : R;
        voffA[i] = (unsigned)(R * K + C) * 2u; voffB[i] = (unsigned)(Rb * K + C) * 2u; }
    const size_t kstep = (size_t)(BK * 2);
    const size_t hstep = (size_t)HALF * K * 2;
    const size_t hstepB = Epi::BPERM ? (size_t)8 * K * 2 : hstep;
    const size_t tstep = 2 * hstep;
    const unsigned ldsw = (unsigned)wid * 1024u;
    const int aoff = lds_byte(wr * 64 + fr, fq * 8), boff = lds_byte(wc * 32 + fr, fq * 8);
#define PG8_SA(b, h) (((b) * 2 + (h)) * HTB)
#define PG8_SB(b, h) ((4 + (b) * 2 + (h)) * HTB)
#define PG8_STAGE(bufoff, gbase, voff) do { _Pragma("unroll") for (int _i = 0; _i < 2; ++_i) \
        __builtin_amdgcn_global_load_lds((const unsigned*)((const char*)(gbase) + (voff)[_i]), (LAS unsigned*)(lds + (bufoff) + ldsw + _i * 8192), 16, 0, 0); } while (0)
#define PG8_LDA(dst, b, h) do { _Pragma("unroll") for (int m = 0; m < 4; ++m) _Pragma("unroll") for (int k = 0; k < 2; ++k) dst[m][k] = *(const LAS bf16x8*)(lds + PG8_SA(b, h) + aoff + m * 2048 + k * 1024); } while (0)
#define PG8_LDB(dst, b, h) do { _Pragma("unroll") for (int n = 0; n < 2; ++n) _Pragma("unroll") for (int k = 0; k < 2; ++k) dst[n][k] = *(const LAS bf16x8*)(lds + PG8_SB(b, h) + boff + n * 2048 + k * 1024); } while (0)
#define PG8_MMA(ai, bj, At, Bt) do { __builtin_amdgcn_s_setprio(1); _Pragma("unroll") for (int m = 0; m < 4; ++m) _Pragma("unroll") for (int n = 0; n < 2; ++n) _Pragma("unroll") for (int k = 0; k < 2; ++k) \
        acc[ai][bj][m][n] = __builtin_amdgcn_mfma_f32_16x16x32_bf16(Bt[n][k], At[m][k], acc[ai][bj][m][n], 0, 0, 0); __builtin_amdgcn_s_setprio(0); } while (0)
#define PG8_WAIT_V(n) asm volatile("s_waitcnt vmcnt(" #n ")" ::: "memory")
#define PG8_WAIT_L(n) asm volatile("s_waitcnt lgkmcnt(" #n ")" ::: "memory")
#define PG8_BAR __builtin_amdgcn_s_barrier()
#define PG8_SCHED __builtin_amdgcn_sched_barrier(0)
    Unit cur, nxt; int ui = 0;
    if (!S.next(0, cur)) return;
    f32x4 acc[2][2][4][2];
#pragma unroll
    for (int a = 0; a < 2; ++a)
#pragma unroll
        for (int b = 0; b < 2; ++b)
#pragma unroll
            for (int m = 0; m < 4; ++m)
#pragma unroll
                for (int n = 0; n < 2; ++n) acc[a][b][m][n] = (f32x4){0.f, 0.f, 0.f, 0.f};
    bf16x8 At[4][2], B0[2][2], B1[2][2];
    const char* cA = (const char*)g.A + (size_t)cur.pm * tstep; const char* cB = (const char*)g.Bt + (size_t)cur.pn * tstep;
    PG8_STAGE(PG8_SB(0, 0), cB, voffB); PG8_STAGE(PG8_SA(0, 0), cA, voffA); PG8_STAGE(PG8_SB(0, 1), cB + hstepB, voffB); PG8_STAGE(PG8_SA(0, 1), cA + hstep, voffA);
    if (wr == 1) PG8_BAR;
    PG8_WAIT_V(4); PG8_BAR;
    PG8_STAGE(PG8_SB(1, 0), cB + kstep, voffB); PG8_STAGE(PG8_SA(1, 0), cA + kstep, voffA); PG8_STAGE(PG8_SB(1, 1), cB + hstepB + kstep, voffB);
    PG8_WAIT_V(6); PG8_BAR;
    for (;;) {
        const bool has_next = S.next(ui + 1, nxt);
        const char* nA = has_next ? (const char*)g.A + (size_t)nxt.pm * tstep : cA; const char* nB = has_next ? (const char*)g.Bt + (size_t)nxt.pn * tstep : cB;
        for (int t = 0; t < nt; t += 2) {
            const bool last = (t == nt - 2);
            const char* a1 = cA + (size_t)(t + 1) * kstep;
            const char* a2 = last ? nA : cA + (size_t)(t + 2) * kstep; const char* b2 = last ? nB : cB + (size_t)(t + 2) * kstep;
            const char* a3 = a2 + kstep; const char* b3 = b2 + kstep;
            PG8_LDB(B0, 0, 0); PG8_SCHED; PG8_LDA(At, 0, 0); PG8_STAGE(PG8_SA(1, 1), a1 + hstep, voffA);
            PG8_WAIT_L(8); PG8_BAR; PG8_WAIT_L(0); PG8_MMA(0, 0, At, B0); PG8_BAR; PG8_SCHED;
            PG8_LDB(B1, 0, 1); PG8_STAGE(PG8_SB(0, 0), b2, voffB);
            PG8_BAR; PG8_WAIT_L(0); PG8_MMA(0, 1, At, B1); PG8_BAR;
            PG8_LDA(At, 0, 1); PG8_STAGE(PG8_SA(0, 0), a2, voffA);
            PG8_BAR; PG8_WAIT_L(0); PG8_MMA(1, 0, At, B0); PG8_BAR; PG8_SCHED;
            PG8_STAGE(PG8_SB(0, 1), b2 + hstepB, voffB);
            PG8_WAIT_V(6); PG8_BAR; PG8_MMA(1, 1, At, B1); PG8_BAR;
            PG8_LDB(B0, 1, 0); PG8_SCHED; PG8_LDA(At, 1, 0); PG8_STAGE(PG8_SA(0, 1), a2 + hstep, voffA);
            PG8_WAIT_L(8); PG8_BAR; PG8_WAIT_L(0); PG8_MMA(0, 0, At, B0); PG8_BAR; PG8_SCHED;
            PG8_LDB(B1, 1, 1); PG8_STAGE(PG8_SB(1, 0), b3, voffB);
            PG8_BAR; PG8_WAIT_L(0); PG8_MMA(0, 1, At, B1); PG8_BAR;
            PG8_LDA(At, 1, 1); PG8_STAGE(PG8_SA(1, 0), a3, voffA);
            PG8_BAR; PG8_WAIT_L(0); PG8_MMA(1, 0, At, B0); PG8_BAR; PG8_SCHED;
            PG8_STAGE(PG8_SB(1, 1), b3 + hstepB, voffB);
            PG8_WAIT_V(6); PG8_BAR; PG8_MMA(1, 1, At, B1); PG8_BAR;
        }
        E(acc, cur, wr, wc, fr, fq);
        if (!has_next) break;
#pragma unroll
        for (int a = 0; a < 2; ++a)
#pragma unroll
            for (int b = 0; b < 2; ++b)
#pragma unroll
                for (int m = 0; m < 4; ++m)
#pragma unroll
                    for (int n = 0; n < 2; ++n) acc[a][b][m][n] = (f32x4){0.f, 0.f, 0.f, 0.f};
        cur = nxt; cA = nA; cB = nB; ++ui;
    }
    PG8_WAIT_V(0);
    if (wr == 0) PG8_BAR;
    PG8_BAR;
#undef PG8_SA
#undef PG8_SB
#undef PG8_STAGE
#undef PG8_LDA
#undef PG8_LDB
#undef PG8_MMA
#undef PG8_WAIT_V
#undef PG8_WAIT_L
#undef PG8_BAR
#undef PG8_SCHED
}
}
using pg8::Unit;

__device__ __forceinline__ unsigned cvt_pk_bf16(float lo, float hi) { unsigned r; asm("v_cvt_pk_bf16_f32 %0, %1, %2" : "=v"(r) : "v"(lo), "v"(hi)); return r; }

struct EpiIn {
    static constexpr bool BPERM = true;
    bf16_t* P; const float* qg; const float* kg; float* outk_p; float* outk_s;
    __device__ __forceinline__ void operator()(const f32x4 (&acc)[2][2][4][2], const Unit& u, int wr, int wc, int fr, int fq) const {
        const int pn = u.pn;
        const int kind = (pn >= 3 && pn < 6) ? 1 : ((pn >= 6 && pn < 9) ? 2 : 0);
        const int col0 = pn * 256 + wc * 64 + 16 * fq;
        f32x4 gv[2][2];
        const float* gp = kind == 1 ? qg : kg;
#pragma unroll
        for (int bj = 0; bj < 2; ++bj)
#pragma unroll
            for (int n = 0; n < 2; ++n) {
                if (kind) { gv[bj][n] = *(const f32x4*)(gp + 16 * fq + 8 * bj + 4 * n); if (kind == 1) gv[bj][n] = gv[bj][n] * (0.125f * LOG2E); }
                else gv[bj][n] = (f32x4){1.f, 1.f, 1.f, 1.f};
            }
#pragma unroll
        for (int ai = 0; ai < 2; ++ai)
#pragma unroll
            for (int m = 0; m < 4; ++m) {
                const int r = u.pm * 256 + ai * 128 + wr * 64 + m * 16 + fr;
                float rstd = 1.0f;
                if (kind) {
                    float ss = 0.f;
#pragma unroll
                    for (int bj = 0; bj < 2; ++bj)
#pragma unroll
                        for (int n = 0; n < 2; ++n)
#pragma unroll
                            for (int e = 0; e < 4; ++e) ss += acc[ai][bj][m][n][e] * acc[ai][bj][m][n][e];
                    ss += __shfl_xor(ss, 16); ss += __shfl_xor(ss, 32);
                    rstd = rsqrtf(ss * (1.0f / 64.0f) + 1e-6f);
                }
                f32x4 v[2][2];
#pragma unroll
                for (int bj = 0; bj < 2; ++bj)
#pragma unroll
                    for (int n = 0; n < 2; ++n) v[bj][n] = acc[ai][bj][m][n] * gv[bj][n] * rstd;
                if (r < TTOK) {
                    u32x4 o0, o1;
                    o0[0] = cvt_pk_bf16(v[0][0][0], v[0][0][1]); o0[1] = cvt_pk_bf16(v[0][0][2], v[0][0][3]); o0[2] = cvt_pk_bf16(v[0][1][0], v[0][1][1]); o0[3] = cvt_pk_bf16(v[0][1][2], v[0][1][3]);
                    o1[0] = cvt_pk_bf16(v[1][0][0], v[1][0][1]); o1[1] = cvt_pk_bf16(v[1][0][2], v[1][0][3]); o1[2] = cvt_pk_bf16(v[1][1][0], v[1][1][1]); o1[3] = cvt_pk_bf16(v[1][1][2], v[1][1][3]);
                    bf16_t* dst = P + (size_t)r * PROJ + col0;
                    *(u32x4*)dst = o0; *(u32x4*)(dst + 8) = o1;
                    if (kind == 2 && r >= SEQ - CACHE) {
                        float* od = r < SEQ ? outk_p + (size_t)(r - (SEQ - CACHE)) * 768 + (col0 - 1536) : outk_s + (size_t)(r - SEQ) * 768 + (col0 - 1536);
                        *(f32x4*)(od) = v[0][0]; *(f32x4*)(od + 4) = v[0][1]; *(f32x4*)(od + 8) = v[1][0]; *(f32x4*)(od + 12) = v[1][1];
                    }
                }
            }
    }
};
struct EpiV {
    static constexpr bool BPERM = true;
    bf16_t *VT1, *VT2, *VT3; float* outv_p; float* outv_s; LAS unsigned char* xb;
    __device__ __forceinline__ void operator()(const f32x4 (&acc)[2][2][4][2], const Unit& u, int wr, int wc, int fr, int fq) const {
        LAS unsigned char* xw = xb + (wr * 4 + wc) * 2304;
        const int tw = u.pn * 256 + wc * 64;
        const int t0 = tw + 16 * fq;
        const int lane = fr + 16 * fq;
#pragma unroll
        for (int ai = 0; ai < 2; ++ai)
#pragma unroll
            for (int m = 0; m < 4; ++m) {
                const int fbase = u.pm * 256 + ai * 128 + wr * 64 + m * 16 - 2304;
                const int fv = fbase + fr;
                if (tw < SEQ) {
                    u32x4 o0, o1;
                    o0[0] = cvt_pk_bf16(acc[ai][0][m][0][0], acc[ai][0][m][0][1]); o0[1] = cvt_pk_bf16(acc[ai][0][m][0][2], acc[ai][0][m][0][3]);
                    o0[2] = cvt_pk_bf16(acc[ai][0][m][1][0], acc[ai][0][m][1][1]); o0[3] = cvt_pk_bf16(acc[ai][0][m][1][2], acc[ai][0][m][1][3]);
                    o1[0] = cvt_pk_bf16(acc[ai][1][m][0][0], acc[ai][1][m][0][1]); o1[1] = cvt_pk_bf16(acc[ai][1][m][0][2], acc[ai][1][m][0][3]);
                    o1[2] = cvt_pk_bf16(acc[ai][1][m][1][0], acc[ai][1][m][1][1]); o1[3] = cvt_pk_bf16(acc[ai][1][m][1][2], acc[ai][1][m][1][3]);
                    bf16_t* d1 = VT1 + (size_t)fv * SEQ + t0;
                    { u32x4 p0, p1; p0[0] = o0[0]; p0[1] = o0[1]; p0[2] = o1[0]; p0[3] = o1[1]; p1[0] = o0[2]; p1[1] = o0[3]; p1[2] = o1[2]; p1[3] = o1[3];
                      *(u32x4*)d1 = p0; *(u32x4*)(d1 + 8) = p1; }
#pragma unroll
                    for (int e = 0; e < 4; ++e) {
                        u32x2 w2; w2[0] = cvt_pk_bf16(acc[ai][0][m][0][e], acc[ai][0][m][1][e]); w2[1] = cvt_pk_bf16(acc[ai][1][m][0][e], acc[ai][1][m][1][e]);
                        { const int si = t0 >> 2, qq = (si >> 2) & 3, qp = ((qq & 1) << 1) | (qq >> 1);
                          *(u32x2*)(VT2 + (size_t)fv * SEQ + e * 4096 + (si & ~15) + 4 * qp) = w2; }
                    }
                    *(LAS u32x4*)(xw + fr * 144 + fq * 32) = o0; *(LAS u32x4*)(xw + fr * 144 + fq * 32 + 16) = o1;
#pragma unroll
                    for (int k = 0; k < 4; ++k) {
                        const int id = lane + 64 * k, f2 = id & 15, rho = id >> 4;
                        const LAS unsigned short* src = (const LAS unsigned short*)(xw + f2 * 144 + rho * 2);
                        const unsigned a0 = src[0], a1 = src[16], a2 = src[32], a3 = src[48];
                        u32x2 w3; w3[0] = a0 | (a1 << 16); w3[1] = a2 | (a3 << 16);
                        { const int si = tw >> 4, qq = (si >> 2) & 3, qp = ((qq & 1) << 1) | (qq >> 1);
                          *(u32x2*)(VT3 + (size_t)(fbase + f2) * SEQ + rho * 1024 + (si & ~15) + 4 * qp) = w3; }
                    }
                    if (tw >= SEQ - CACHE) {
#pragma unroll
                        for (int bj = 0; bj < 2; ++bj)
#pragma unroll
                            for (int n = 0; n < 2; ++n)
#pragma unroll
                                for (int e = 0; e < 4; ++e) outv_p[(size_t)(t0 + 8 * bj + 4 * n + e - (SEQ - CACHE)) * 768 + fv] = acc[ai][bj][m][n][e];
                    }
                } else if (t0 < TTOK) {
#pragma unroll
                    for (int bj = 0; bj < 2; ++bj)
#pragma unroll
                        for (int n = 0; n < 2; ++n)
#pragma unroll
                            for (int e = 0; e < 4; ++e) outv_s[(size_t)(t0 + 8 * bj + 4 * n + e - SEQ) * 768 + fv] = acc[ai][bj][m][n][e];
                }
            }
    }
};
struct EpiOut {
    static constexpr bool BPERM = true;
    const float* xin; float* xo;
    __device__ __forceinline__ void operator()(const f32x4 (&acc)[2][2][4][2], const Unit& u, int wr, int wc, int fr, int fq) const {
        const int c0 = u.pn * 256 + wc * 64 + 16 * fq;
#pragma unroll
        for (int ai = 0; ai < 2; ++ai)
#pragma unroll
            for (int m = 0; m < 4; ++m) {
                const int r = u.pm * 256 + ai * 128 + wr * 64 + m * 16 + fr;
                const float* xi = xin + (size_t)r * 1024 + c0; float* xop = xo + (size_t)r * 1024 + c0;
                f32x4 x[2][2];
#pragma unroll
                for (int bj = 0; bj < 2; ++bj)
#pragma unroll
                    for (int n = 0; n < 2; ++n) x[bj][n] = *(const f32x4*)(xi + 8 * bj + 4 * n);
#pragma unroll
                for (int bj = 0; bj < 2; ++bj)
#pragma unroll
                    for (int n = 0; n < 2; ++n) *(f32x4*)(xop + 8 * bj + 4 * n) = x[bj][n] + acc[ai][bj][m][n];
            }
    }
};
__device__ void sample_outproj(const Params& p, int layer) {
    const int tid = opaque_tid(), dotid = tid >> 2, sub = tid & 3, row = dotid >> 2;
    const float* xi = layer == 0 ? p.x_sample : WSP(p, float, WS_X1) + (size_t)SEQ * 1024;
    float* xo = layer == 0 ? WSP(p, float, WS_X1) + (size_t)SEQ * 1024 : p.out + O_YS;
    for (int cb = blockIdx.x; cb < 256; cb += gridDim.x) {
        const int col = 4 * cb + (dotid & 3);
        const bf16_t* gp = WSP(p, bf16_t, WS_G) + (size_t)(SEQ + row) * 1024 + sub * 256;
        const bf16_t* wp = WSP(p, bf16_t, WS_WOUTT) + (size_t)layer * 1024 * 1024 + (size_t)col * 1024 + sub * 256;
        float a = 0.f;
#pragma unroll 8
        for (int i = 0; i < 32; ++i) {
            const u32x4 gv = *(const u32x4*)(gp + 8 * i), wv = *(const u32x4*)(wp + 8 * i);
#pragma unroll
            for (int j = 0; j < 4; ++j) a += bflo(gv[j]) * bflo(wv[j]) + bfhi(gv[j]) * bfhi(wv[j]);
        }
        a += __shfl_xor(a, 1); a += __shfl_xor(a, 2);
        if (sub == 0) xo[(size_t)row * 1024 + col] = xi[(size_t)row * 1024 + col] + a;
    }
}
__device__ void transpose_tile(const float* __restrict__ src, bf16_t* __restrict__ dst, int K, int N, int tile_id, float* tile) {
    const int tilesN = N / 64, kb = (tile_id / tilesN) * 64, nb = (tile_id % tilesN) * 64, tid = opaque_tid();
    { const int n = tid & 63, k0 = tid >> 6;
#pragma unroll
      for (int i = 0; i < 8; ++i) { const int k = k0 + 8 * i; tile[k * 65 + n] = src[(size_t)(kb + k) * N + nb + n]; } }
    __syncthreads();
    { const int k = tid & 63, n0 = tid >> 6;
#pragma unroll
      for (int i = 0; i < 8; ++i) { const int n = n0 + 8 * i; dst[(size_t)(nb + n) * K + kb + k] = f2bf(tile[k * 65 + n]); } }
    __syncthreads();
}

__device__ void rmsnorm_rows(const Params& p, int layer) {
    const int tid = opaque_tid(), lane = tid & 63, wg = blockIdx.x * 8 + (tid >> 6), nw = gridDim.x * 8;
    const float* g = p.norm_g + layer * 1024;
    for (int row = wg; row < TTOK; row += nw) {
        const float* src = layer == 0 ? (row < SEQ ? p.x_prompt + (size_t)row * 1024 : p.x_sample + (size_t)(row - SEQ) * 1024) : WSP(p, float, WS_X1) + (size_t)row * 1024;
        f32x4 v[4]; float ss = 0.f;
#pragma unroll
        for (int i = 0; i < 4; ++i) { v[i] = *(const f32x4*)(src + i * 256 + lane * 4); ss += v[i][0] * v[i][0] + v[i][1] * v[i][1] + v[i][2] * v[i][2] + v[i][3] * v[i][3]; }
#pragma unroll
        for (int o = 32; o >= 1; o >>= 1) ss += __shfl_xor(ss, o);
        const float rstd = rsqrtf(ss * (1.0f / 1024.0f) + 1e-6f);
#pragma unroll
        for (int i = 0; i < 4; ++i) { const f32x4 gv = *(const f32x4*)(g + i * 256 + lane * 4); const f32x4 y = v[i] * rstd * gv;
            u32x2 o; o[0] = pk2(y[0], y[1]); o[1] = pk2(y[2], y[3]); *(u32x2*)(WSP(p, bf16_t, WS_HB) + (size_t)row * 1024 + i * 256 + lane * 4) = o; }
    }
}

struct KVf { bf16x8 k[4]; bf16x8 v[2][2]; };
struct TileGeom { int pat, tt, kt, qb, ldil; };
__device__ __forceinline__ TileGeom tile_geom(int it, int w) {
    TileGeom g; g.pat = it >= 20 ? 2 : (it >= 10 ? 1 : 0); const int rem = it - 10 * g.pat; g.tt = rem >= 5 ? 1 : 0; g.kt = rem - 5 * g.tt;
    const int tl = w + 8 * g.tt; g.qb = g.pat == 0 ? 32 * tl : (g.pat == 1 ? 128 * (tl >> 2) + (tl & 3) : tl); g.ldil = 2 * g.pat; return g;
}
__device__ __forceinline__ void load_kv(KVf& f, const bf16_t* __restrict__ kbase  , const bf16_t* __restrict__ vt1h  , int it, int w, int T0, int c) {
    const TileGeom g = tile_geom(it, w);
    const int dil = 1 << g.ldil, qbase = T0 + g.qb, vidx0 = qbase >> g.ldil, res = qbase & (dil - 1), kk0 = -128 + 32 * g.kt;
    int kpos = qbase + dil * (kk0 + c); kpos = kpos < 0 ? 0 : kpos;
    const bf16_t* kp = kbase + (size_t)kpos * PROJ;
#pragma unroll
    for (int s = 0; s < 4; ++s) f.k[s] = *(const bf16x8*)(kp + 16 * s);
    const bf16_t* vrow = vt1h + (size_t)g.pat * ((size_t)768 * SEQ) + (size_t)res * (SEQ >> g.ldil);
#pragma unroll
    for (int s2 = 0; s2 < 2; ++s2) {
        int gi = vidx0 + kk0 + 16 * s2; gi = gi < 0 ? 0 : gi;
#pragma unroll
        for (int mt = 0; mt < 2; ++mt) f.v[mt][s2] = *(const bf16x8*)(vrow + (size_t)(32 * mt) * SEQ + gi);
    }
}
template <bool MASK>
__device__ __forceinline__ void attn_tile(const KVf& f, const bf16x8 (&qf)[4], f32x16& O0, f32x16& O1, float& den, float dsl, float base, int kk0, int vidx0, int c, int hh) {
    f32x16 S;
#pragma unroll
    for (int r = 0; r < 16; ++r) S[r] = fmaf(dsl, (float)((r & 3) + 8 * (r >> 2)), base);
#pragma unroll
    for (int s = 0; s < 4; ++s) S = __builtin_amdgcn_mfma_f32_32x32x16_bf16(f.k[s], qf[s], S, 0, 0, 0);
#pragma unroll
    for (int r = 0; r < 16; ++r) {
        float pv = __builtin_amdgcn_exp2f(S[r]);
        if (MASK) { const int kk = kk0 + (r & 3) + 8 * (r >> 2) + 4 * hh; const int dd = c - kk; const bool valid = (dd >= 0) && (dd <= 128) && (vidx0 + kk >= 0); pv = valid ? pv : 0.f; }
        den += pv; S[r] = pv;
    }
#pragma unroll
    for (int s2 = 0; s2 < 2; ++s2) {
        u32x4 pw;
#pragma unroll
        for (int j = 0; j < 4; ++j) pw[j] = cvt_pk_bf16(S[8 * s2 + 2 * j], S[8 * s2 + 2 * j + 1]);
        const bf16x8 pf = __builtin_bit_cast(bf16x8, pw);
        O0 = __builtin_amdgcn_mfma_f32_32x32x16_bf16(f.v[0][s2], pf, O0, 0, 0, 0);
        O1 = __builtin_amdgcn_mfma_f32_32x32x16_bf16(f.v[1][s2], pf, O1, 0, 0, 0);
    }
}

__device__ void attn_item(const Params& p, int layer, int sb, int h, float* accL, float Mref2) {
    const int tid = opaque_tid(), w = tid >> 6, lane = tid & 63, c = lane & 31, hh = lane >> 5;
    const int T0 = sb * 512;
    const float sl2 = exp2f(-8.0f * (float)(h + 1) / 12.0f) * LOG2E;
    const bf16_t* __restrict__ P = WSP(p, bf16_t, WS_P);
    const bf16_t* __restrict__ kbase = P + 1536 + h * 64 + 8 * hh;
    const bf16_t* __restrict__ qbasep = P + 768 + h * 64 + 8 * hh;
    const bf16_t* __restrict__ vt1h = WSP(p, bf16_t, WS_VT1) + (size_t)(h * 64 + c) * SEQ + 8 * hh;
    KVf f0, f1, f2;
    bf16x8 qf[4];
    f32x16 O0, O1; float den = 0.f;
#pragma unroll
    for (int r = 0; r < 16; ++r) { O0[r] = 0.f; O1[r] = 0.f; }
    { const TileGeom g = tile_geom(0, w); const bf16_t* qp = qbasep + (size_t)(T0 + g.qb + (c << g.ldil)) * PROJ;
#pragma unroll
      for (int s = 0; s < 4; ++s) qf[s] = *(const bf16x8*)(qp + 16 * s); }
    load_kv(f0, kbase, vt1h, 0, w, T0, c);
    load_kv(f1, kbase, vt1h, 1, w, T0, c);
#define ATTN_STEP(FA, FC, IT) { \
        const int it_ = (IT); \
        if (it_ + 2 < 30) load_kv(FC, kbase, vt1h, it_ + 2, w, T0, c); \
        const TileGeom g = tile_geom(it_, w); \
        const int dil = 1 << g.ldil, qbase = T0 + g.qb, vidx0 = qbase >> g.ldil, kk0 = -128 + 32 * g.kt; \
        if (g.kt == 0) { _Pragma("unroll") for (int r = 0; r < 16; ++r) { O0[r] = 0.f; O1[r] = 0.f; } den = 0.f; } \
        const float dsl = sl2 * (float)dil; \
        const float base = dsl * (float)(kk0 - c + 4 * hh) - Mref2; \
        if (g.kt == 0 || g.kt == 4 || vidx0 < 128) attn_tile<true>(FA, qf, O0, O1, den, dsl, base, kk0, vidx0, c, hh); \
        else attn_tile<false>(FA, qf, O0, O1, den, dsl, base, kk0, vidx0, c, hh); \
        if (g.kt == 4) { \
            if (it_ + 1 < 30) { const TileGeom gn = tile_geom(it_ + 1, w); const bf16_t* qp = qbasep + (size_t)(T0 + gn.qb + (c << gn.ldil)) * PROJ; \
                _Pragma("unroll") for (int s = 0; s < 4; ++s) qf[s] = *(const bf16x8*)(qp + 16 * s); } \
            const float dt = den + __shfl_xor(den, 32); \
            float* arow = accL + (g.qb + (c << g.ldil)) * 65; \
            if (g.pat == 0) { \
                _Pragma("unroll") for (int r = 0; r < 16; ++r) { const int d = (r & 3) + 8 * (r >> 2) + 4 * hh; arow[d] = O0[r]; arow[32 + d] = O1[r]; } \
                if (hh == 0) arow[64] = dt; \
            } else { \
                _Pragma("unroll") for (int r = 0; r < 16; ++r) { const int d = (r & 3) + 8 * (r >> 2) + 4 * hh; arow[d] += O0[r]; arow[32 + d] += O1[r]; } \
                if (hh == 0) arow[64] += dt; \
            } \
            if (g.tt == 1) __syncthreads(); \
        } }
#pragma unroll 1
    for (int it = 0; it < 30; it += 3) {
        ATTN_STEP(f0, f2, it);
        ATTN_STEP(f1, f0, it + 1);
        ATTN_STEP(f2, f1, it + 2);
    }
#undef ATTN_STEP
    bf16_t* __restrict__ Gp = WSP(p, bf16_t, WS_G);
#pragma unroll 1
    for (int it = 0; it < 4; ++it) {
        unsigned zb[8];
#pragma unroll
        for (int j = 0; j < 8; ++j) { const int idx = tid + NTHREADS * (it * 8 + j); const int ql = idx >> 5, d2 = (idx & 31) * 2;
            zb[j] = *(const unsigned*)(P + (size_t)(T0 + ql) * PROJ + 3072 + h * 64 + d2); }
#pragma unroll
        for (int j = 0; j < 8; ++j) { const int idx = tid + NTHREADS * (it * 8 + j); const int ql = idx >> 5, d2 = (idx & 31) * 2;
            const float inv = 1.0f / accL[ql * 65 + 64];
            const float o0 = accL[ql * 65 + d2] * inv * silu(bflo(zb[j])), o1 = accL[ql * 65 + d2 + 1] * inv * silu(bfhi(zb[j]));
            *(unsigned*)(Gp + (size_t)(T0 + ql) * 1024 + 256 + h * 64 + d2) = cvt_pk_bf16(o0, o1); }
    }
    __syncthreads();
}

__device__ void sgu_item(const Params& p, int layer, int ch, int g, bf16_t* vnT  ) {
    const int tid = opaque_tid(), w = tid >> 6, lane = tid & 63, c = lane & 31, hh = lane >> 5;
    const int R0 = ch * 128;
    const bf16_t* __restrict__ P = WSP(p, bf16_t, WS_P);
    const float* sg = p.sgu_g + layer * 256;
    const int tt = w >> 1, dt = w & 1;
    const int t = 32 * tt + c;
    const float* wrow = p.w_sp + ((size_t)(layer * 4 + g) * 128 + t) * 128 + 8 * hh;
    u32x2 vv[16];
#pragma unroll
    for (int rr = 0; rr < 16; ++rr) vv[rr] = *(const u32x2*)(P + (size_t)(R0 + w * 16 + rr) * PROJ + 256 + lane * 4);
    f32x4 w0[8], w1[8];
#pragma unroll
    for (int ks = 0; ks < 8; ++ks) { if (ks <= 2 * tt + 1) { w0[ks] = *(const f32x4*)(wrow + 16 * ks); w1[ks] = *(const f32x4*)(wrow + 16 * ks + 4); } else { w0[ks] = (f32x4){0.f, 0.f, 0.f, 0.f}; w1[ks] = w0[ks]; } }
    const f32x4 gv = *(const f32x4*)(sg + g * 64 + (lane & 15) * 4);
#pragma unroll
    for (int rr = 0; rr < 16; ++rr) {
        const int row = w * 16 + rr;
        const float f0 = bflo(vv[rr][0]), f1 = bfhi(vv[rr][0]), f2 = bflo(vv[rr][1]), f3 = bfhi(vv[rr][1]);
        float ss = f0 * f0 + f1 * f1 + f2 * f2 + f3 * f3;
#pragma unroll
        for (int o = 32; o >= 1; o >>= 1) ss += __shfl_xor(ss, o);
        const float rstd = rsqrtf(ss * (1.0f / 256.0f) + 1e-6f);
        if ((lane >> 4) == g) {
            const int dl = (lane & 15) * 4;
            vnT[(dl + 0) * 136 + row] = f2bf(f0 * rstd * gv[0]); vnT[(dl + 1) * 136 + row] = f2bf(f1 * rstd * gv[1]);
            vnT[(dl + 2) * 136 + row] = f2bf(f2 * rstd * gv[2]); vnT[(dl + 3) * 136 + row] = f2bf(f3 * rstd * gv[3]);
        }
    }
    const float* bsp = p.b_sp + (size_t)(layer * 4 + g) * 128;
    const int colA = g * 64 + 32 * dt + c;
    bf16_t uav[16], zav[16]; float bv[16];
#pragma unroll
    for (int r = 0; r < 16; ++r) { const int tr = 32 * tt + (r & 3) + 8 * (r >> 2) + 4 * hh; const size_t row = (size_t)(R0 + tr);
        uav[r] = P[row * PROJ + colA]; zav[r] = P[row * PROJ + 512 + colA]; bv[r] = bsp[tr]; }
    __syncthreads();
    f32x16 acc;
#pragma unroll
    for (int r = 0; r < 16; ++r) acc[r] = 0.f;
#pragma unroll
    for (int ks = 0; ks < 8; ++ks) {
        if (ks <= 2 * tt + 1) {
            const int s0 = 16 * ks + 8 * hh;
            u32x4 aw;
            aw[0] = cvt_pk_bf16(s0 + 0 <= t ? w0[ks][0] : 0.f, s0 + 1 <= t ? w0[ks][1] : 0.f); aw[1] = cvt_pk_bf16(s0 + 2 <= t ? w0[ks][2] : 0.f, s0 + 3 <= t ? w0[ks][3] : 0.f);
            aw[2] = cvt_pk_bf16(s0 + 4 <= t ? w1[ks][0] : 0.f, s0 + 5 <= t ? w1[ks][1] : 0.f); aw[3] = cvt_pk_bf16(s0 + 6 <= t ? w1[ks][2] : 0.f, s0 + 7 <= t ? w1[ks][3] : 0.f);
            const bf16x8 bfrag = *(const bf16x8*)(vnT + (32 * dt + c) * 136 + s0);
            acc = __builtin_amdgcn_mfma_f32_32x32x16_bf16(__builtin_bit_cast(bf16x8, aw), bfrag, acc, 0, 0, 0);
        }
    }
    bf16_t* __restrict__ Gp = WSP(p, bf16_t, WS_G);
#pragma unroll
    for (int r = 0; r < 16; ++r) {
        const int tr = 32 * tt + (r & 3) + 8 * (r >> 2) + 4 * hh;
        Gp[(size_t)(R0 + tr) * 1024 + colA] = f2bf(bf2f(uav[r]) * (acc[r] + bv[r]) * silu(bf2f(zav[r])));
    }
    __syncthreads();
}

__device__ void sattn_item(const Params& p, int layer, int b, int h, float* part  , float Mref) {
    const int tid = opaque_tid();
    const float slope = exp2f(-8.0f * (float)(h + 1) / 12.0f);
    const size_t tok = (size_t)(SEQ + b);
    const bf16_t* __restrict__ P = WSP(p, bf16_t, WS_P);
    const float* ck = p.cache_k + ((size_t)(layer * NS + b) * CACHE) * 768 + h * 64;
    const float* cv = p.cache_v + ((size_t)(layer * NS + b) * CACHE) * 768 + h * 64;
    const float* nk = p.out + O_KS + ((size_t)(layer * NS + b)) * 768 + h * 64;
    const float* nv = p.out + O_VS + ((size_t)(layer * NS + b)) * 768 + h * 64;
    const int sub = tid & 15, grp = tid >> 4;
    f32x4 k4[13], v4[13];
#pragma unroll
    for (int it = 0; it < 13; ++it) {
        const int e = it * 32 + grp; const int ee = e < 387 ? e : 0; const int pat = ee >= 258 ? 2 : (ee >= 129 ? 1 : 0); const int j = ee - pat * 129; const int dist = j << (2 * pat);
        const float* kr = dist == 0 ? nk : ck + (size_t)(CACHE - dist) * 768;
        const float* vr = dist == 0 ? nv : cv + (size_t)(CACHE - dist) * 768;
        k4[it] = *(const f32x4*)(kr + sub * 4); v4[it] = *(const f32x4*)(vr + sub * 4);
    }
    f32x4 q4;
    { const u32x2 qv = *(const u32x2*)(P + tok * PROJ + 768 + h * 64 + sub * 4); q4[0] = bflo(qv[0]); q4[1] = bfhi(qv[0]); q4[2] = bflo(qv[1]); q4[3] = bfhi(qv[1]); }
    const float zbv = tid < 64 ? bf2f(P[tok * PROJ + 3072 + h * 64 + tid]) : 0.f;
    f32x4 acc = (f32x4){0.f, 0.f, 0.f, 0.f}; float den = 0.f;
#pragma unroll
    for (int it = 0; it < 13; ++it) {
        const int e = it * 32 + grp; const bool act = e < 387; const int ee = act ? e : 0; const int pat = ee >= 258 ? 2 : (ee >= 129 ? 1 : 0); const int j = ee - pat * 129; const int dist = j << (2 * pat);
        float d = q4[0] * k4[it][0] + q4[1] * k4[it][1] + q4[2] * k4[it][2] + q4[3] * k4[it][3];
        d += __shfl_xor(d, 1); d += __shfl_xor(d, 2); d += __shfl_xor(d, 4); d += __shfl_xor(d, 8);
        const float pe = act ? __builtin_amdgcn_exp2f(d - slope * LOG2E * (float)dist - Mref * LOG2E) : 0.f;
        acc += v4[it] * pe; den += pe;
    }
    *(f32x4*)(part + grp * 68 + sub * 4) = acc; if (sub == 0) part[grp * 68 + 64] = den;
    __syncthreads();
    if (tid < 64) {
        float num = 0.f, dn = 0.f;
#pragma unroll
        for (int k = 0; k < 32; ++k) { num += part[k * 68 + tid]; dn += part[k * 68 + 64]; }
        WSP(p, bf16_t, WS_G)[tok * 1024 + 256 + h * 64 + tid] = f2bf(num / dn * silu(zbv));
    }
    __syncthreads();
}

__device__ void ssgu_item(const Params& p, int layer) {
    const int tid = opaque_tid(), w = tid >> 6, lane = tid & 63;
    const float* sg = p.sgu_g + layer * 256;
    const bf16_t* __restrict__ P = WSP(p, bf16_t, WS_P);
    for (int rr = 0; rr < 4; ++rr) {
        const int b = w * 4 + rr; const size_t tok = (size_t)(SEQ + b);
        const u32x2 v = *(const u32x2*)(P + tok * PROJ + 256 + lane * 4);
        const u32x2 uav = *(const u32x2*)(P + tok * PROJ + lane * 4), zav = *(const u32x2*)(P + tok * PROJ + 512 + lane * 4);
        float f[4] = {bflo(v[0]), bfhi(v[0]), bflo(v[1]), bfhi(v[1])};
        float ss = f[0] * f[0] + f[1] * f[1] + f[2] * f[2] + f[3] * f[3];
#pragma unroll
        for (int o = 32; o >= 1; o >>= 1) ss += __shfl_xor(ss, o);
        const float rstd = rsqrtf(ss * (1.0f / 256.0f) + 1e-6f);
        const int g = lane >> 4;
        const float w00 = p.w_sp[(size_t)(layer * 4 + g) * 128 * 128], b0 = p.b_sp[(size_t)(layer * 4 + g) * 128];
        const float ua[4] = {bflo(uav[0]), bfhi(uav[0]), bflo(uav[1]), bfhi(uav[1])}, za[4] = {bflo(zav[0]), bfhi(zav[0]), bflo(zav[1]), bfhi(zav[1])};
        const f32x4 gv = *(const f32x4*)(sg + lane * 4);
        f32x4 vn; float o[4];
#pragma unroll
        for (int e = 0; e < 4; ++e) { vn[e] = f[e] * rstd * gv[e]; o[e] = ua[e] * (w00 * vn[e] + b0) * silu(za[e]); }
        *(f32x4*)(p.out + O_SG + ((size_t)(layer * NS + b)) * 256 + lane * 4) = vn;
        u32x2 go; go[0] = pk2(o[0], o[1]); go[1] = pk2(o[2], o[3]);
        *(u32x2*)(WSP(p, bf16_t, WS_G) + tok * 1024 + lane * 4) = go;
    }
    __syncthreads();
}

__global__ void __launch_bounds__(NTHREADS, 2) hymba_fwd(Params p) {
    extern __shared__ __attribute__((aligned(16))) unsigned char shm[];
    cg::grid_group grid = cg::this_grid();
    const int G = gridDim.x, c = blockIdx.x;
    for (int ph = p.phase_lo; ph < p.phase_hi; ++ph) {
        if (ph > p.phase_lo) grid.sync();
        const int layer = ph >> 2, kind = ph & 3;
#ifdef DUP_KIND
        for (int rep = 0; rep < ((kind == DUP_KIND) ? 2 : 1); ++rep) {
            if (rep) __syncthreads();
#endif
        if (kind == 0) {
            if (layer == 0) {
                if (c == 0 && threadIdx.x < 8) WSP(p, int, WS_CTL)[threadIdx.x] = 0;
                float* tile = (float*)shm;
                for (int t = c; t < 2432; t += G) {
                    int tt = t; const int l = tt / 1216; tt -= l * 1216;
                    if (tt < 960) transpose_tile(p.w_in + (size_t)l * 1024 * PROJ, WSP(p, bf16_t, WS_WINT) + (size_t)l * PROJ * 1024, 1024, PROJ, tt, tile);
                    else transpose_tile(p.w_out + (size_t)l * 1024 * 1024, WSP(p, bf16_t, WS_WOUTT) + (size_t)l * 1024 * 1024, 1024, 1024, tt - 960, tile);
                }
            }
            rmsnorm_rows(p, layer);
        } else if (kind == 1) {
            LAS unsigned char* lds = (LAS unsigned char*)shm;
            const bf16_t* W = WSP(p, bf16_t, WS_WINT) + (size_t)layer * PROJ * 1024;
            {
                pg8::Order S; S.nM = 65; S.nN = 12; S.nwg = 780; S.G = G; S.c = c; S.i0 = 0; S.Loff = 0; S.pm_add = 0; S.pn_skip_from = 9; S.pn_skip_by = 3;
                pg8::Gemm g; g.A = WSP(p, bf16_t, WS_HB); g.Bt = W; g.K = 1024;
                EpiIn E; E.P = WSP(p, bf16_t, WS_P); E.qg = p.qg + layer * 64; E.kg = p.kg + layer * 64; E.outk_p = p.out + O_KP + (size_t)layer * CACHE * 768; E.outk_s = p.out + O_KS + (size_t)layer * NS * 768;
                pg8::gemm_phase<EpiIn>(lds, g, S, E);
            }
            {
                pg8::Order S; S.nM = 3; S.nN = 65; S.nwg = 195; S.G = G; S.c = c; S.i0 = c < 780 ? (780 - c + G - 1) / G : 0; S.Loff = 780; S.pm_add = 9; S.pn_skip_from = 1 << 30; S.pn_skip_by = 0;
                pg8::Gemm g; g.A = W; g.Bt = WSP(p, bf16_t, WS_HB); g.K = 1024;
                EpiV E; E.VT1 = WSP(p, bf16_t, WS_VT1); E.VT2 = WSP(p, bf16_t, WS_VT2); E.VT3 = WSP(p, bf16_t, WS_VT3); E.outv_p = p.out + O_VP + (size_t)layer * CACHE * 768; E.outv_s = p.out + O_VS + (size_t)layer * NS * 768;
                E.xb = lds + LDS_XB;
                pg8::gemm_phase<EpiV>(lds, g, S, E);
            }
        } else if (kind == 2) {
            float gq = 0.f, gk = 0.f;
            for (int i = 0; i < 64; ++i) { gq = fmaxf(gq, fabsf(p.qg[layer * 64 + i])); gk = fmaxf(gk, fabsf(p.kg[layer * 64 + i])); }
            const float Mref = 8.2f * gq * gk;
            int* ctr = WSP(p, int, WS_CTL) + layer
#ifdef DUP_KIND
                + 2 * rep
#endif
                ;
            volatile int* slot = (volatile int*)(shm + LDS_CTL);
            if (threadIdx.x == 0) *slot = atomicAdd(ctr, 1);
            __syncthreads();
            int item = *slot;
            while (item < 1281) {
                __syncthreads();
                int nxt = 0;
                if (threadIdx.x == 0) nxt = atomicAdd(ctr, 1);
#ifdef DUP_ATTN
                if (item < 384) attn_item(p, layer, item / 12, item % 12, (float*)shm, Mref * LOG2E);
#endif
#ifdef DUP_SATTN
                if (item >= 384 && item < 768) sattn_item(p, layer, (item - 384) / 12, (item - 384) % 12, (float*)shm, Mref);
#endif
#ifdef DUP_SGU
                if (item >= 768 && item < 1280) sgu_item(p, layer, (item - 768) >> 2, (item - 768) & 3, (bf16_t*)shm);
#endif
                if (item < 384) attn_item(p, layer, item / 12, item % 12, (float*)shm, Mref * LOG2E);
                else if (item < 768) sattn_item(p, layer, (item - 384) / 12, (item - 384) % 12, (float*)shm, Mref);
                else if (item < 1280) sgu_item(p, layer, (item - 768) >> 2, (item - 768) & 3, (bf16_t*)shm);
                else ssgu_item(p, layer);
                if (threadIdx.x == 0) *slot = nxt;
                __syncthreads();
                item = *slot;
            }
        } else {
            LAS unsigned char* lds = (LAS unsigned char*)shm;
            pg8::Order S; S.nM = 64; S.nN = 4; S.nwg = 256; S.G = G; S.c = c; S.i0 = 0; S.Loff = 0; S.pm_add = 0; S.pn_skip_from = 1 << 30; S.pn_skip_by = 0;
            pg8::Gemm g; g.A = WSP(p, bf16_t, WS_G); g.Bt = WSP(p, bf16_t, WS_WOUTT) + (size_t)layer * 1024 * 1024; g.K = 1024;
            EpiOut E;
            if (layer == 0) { E.xin = p.x_prompt; E.xo = WSP(p, float, WS_X1); }
            else { E.xin = WSP(p, float, WS_X1); E.xo = p.out + O_YP; }
            pg8::gemm_phase<EpiOut>(lds, g, S, E);
            sample_outproj(p, layer);
        }
#ifdef DUP_KIND
        }
#endif
    }
}

#ifndef SINGLE_LAUNCH
#define SINGLE_LAUNCH 1
#endif
extern "C" void kernel_launch(void* const* d_in, const int* in_sizes, int n_in, void* d_out, int out_size, void* d_ws, size_t ws_size, hipStream_t stream) {
    static int grid = 0;
    if (grid == 0) {
        int dev = 0, cus = 0, per_cu = 0;
        hipGetDevice(&dev);
        hipDeviceGetAttribute(&cus, hipDeviceAttributeMultiprocessorCount, dev);
        if (hipFuncSetAttribute((const void*)hymba_fwd, hipFuncAttributeMaxDynamicSharedMemorySize, LDS_BYTES) != hipSuccess) { fprintf(stderr, "hipFuncSetAttribute failed\n"); grid = -1; return; }
        if (hipOccupancyMaxActiveBlocksPerMultiprocessor(&per_cu, (const void*)hymba_fwd, NTHREADS, LDS_BYTES) != hipSuccess || per_cu < 1) { fprintf(stderr, "occupancy query: %d\n", per_cu); per_cu = 1; }
        (void)hipGetLastError();
        if (per_cu > 1) per_cu = 1;
        grid = cus * per_cu;
    }
    if (grid < 0) return;
    Params p{};
    p.x_prompt = (const float*)d_in[0]; p.x_sample = (const float*)d_in[1]; p.cache_k = (const float*)d_in[2]; p.cache_v = (const float*)d_in[3];
    p.norm_g = (const float*)d_in[4]; p.w_in = (const float*)d_in[5]; p.sgu_g = (const float*)d_in[6]; p.w_sp = (const float*)d_in[7]; p.b_sp = (const float*)d_in[8];
    p.qg = (const float*)d_in[9]; p.kg = (const float*)d_in[10]; p.w_out = (const float*)d_in[11];
    p.out = (float*)d_out;
    p.ws = (unsigned char*)d_ws;
    if (ws_size < WS_END) { fprintf(stderr, "workspace too small\n"); return; }
#if SINGLE_LAUNCH
    p.phase_lo = 0; p.phase_hi = 8;
    void* args[] = {&p};
    hipError_t e = hipLaunchCooperativeKernel((const void*)hymba_fwd, dim3(grid), dim3(NTHREADS), args, LDS_BYTES, stream);
    if (e != hipSuccess) fprintf(stderr, "cooperative launch failed: %s (grid %d)\n", hipGetErrorString(e), grid);
#else
    for (int ph = 0; ph < 8; ++ph) { p.phase_lo = ph; p.phase_hi = ph + 1; hipLaunchKernelGGL(hymba_fwd, dim3(grid), dim3(NTHREADS), LDS_BYTES, stream, p); }
#endif
}
```

```cpp
#include <hip/hip_runtime.h>
#include <hip/hip_cooperative_groups.h>
#include <cstdio>
namespace cg = cooperative_groups;

#define LAS __attribute__((address_space(3)))
typedef unsigned short bf16_t;
typedef short bf16x8 __attribute__((ext_vector_type(8)));
typedef float f32x4 __attribute__((ext_vector_type(4)));
typedef float f32x16 __attribute__((ext_vector_type(16)));
typedef unsigned u32x2 __attribute__((ext_vector_type(2)));
typedef unsigned u32x4 __attribute__((ext_vector_type(4)));

constexpr int D_MODEL = 1024, SEQ = 16384, NS = 32, TTOK = SEQ + NS  , MPAD = 16640, PROJ = 3840, CACHE = 2048;
constexpr int NTHREADS = 512;
constexpr int LDS_BYTES = 150 * 1024;
constexpr int LDS_XB = 128 * 1024;
constexpr int LDS_CTL = 150 * 1024 - 16;
constexpr float LOG2E = 1.4426950408889634f;

constexpr size_t O_YP = 0, O_YS = 16777216, O_KP = O_YS + 32768, O_VP = O_KP + 3145728, O_KS = O_VP + 3145728, O_VS = O_KS + 49152, O_SG = O_VS + 49152;

struct Params {
    const float *x_prompt, *x_sample, *cache_k, *cache_v, *norm_g, *w_in, *sgu_g, *w_sp, *b_sp, *qg, *kg, *w_out;
    float* out;
    unsigned char* ws;
    int phase_lo, phase_hi;
};
constexpr size_t al4k(size_t b) { return (b + 4095) & ~(size_t)4095; }
constexpr size_t WS_WINT = 0;
constexpr size_t WS_WOUTT = WS_WINT + al4k((size_t)2 * PROJ * 1024 * 2);
constexpr size_t WS_HB = WS_WOUTT + al4k((size_t)2 * 1024 * 1024 * 2);
constexpr size_t WS_P = WS_HB + al4k((size_t)MPAD * 1024 * 2);
constexpr size_t WS_VT1 = WS_P + al4k((size_t)MPAD * PROJ * 2);
constexpr size_t WS_VT2 = WS_VT1 + al4k((size_t)768 * SEQ * 2);
constexpr size_t WS_VT3 = WS_VT2 + al4k((size_t)768 * SEQ * 2);
constexpr size_t WS_G = WS_VT3 + al4k((size_t)768 * SEQ * 2);
constexpr size_t WS_X1 = WS_G + al4k((size_t)MPAD * 1024 * 2);
constexpr size_t WS_KF = WS_X1 + al4k((size_t)TTOK * 1024 * 4);
constexpr size_t WS_CTL = WS_KF + 3 * al4k((size_t)768 * SEQ * 2);
constexpr size_t WS_END = WS_CTL + 4096;
#define WSP(p, T, OFF) ((T*)((p).ws + (OFF)))

__device__ __forceinline__ bf16_t f2bf(float f) { unsigned u = __float_as_uint(f); u += 0x7FFFu + ((u >> 16) & 1u); return (bf16_t)(u >> 16); }
__device__ __forceinline__ unsigned pk2(float lo, float hi) { return (unsigned)f2bf(lo) | ((unsigned)f2bf(hi) << 16); }
__device__ __forceinline__ float bf2f(bf16_t b) { return __uint_as_float(((unsigned)b) << 16); }
__device__ __forceinline__ float bflo(unsigned u) { return __uint_as_float(u << 16); }
__device__ __forceinline__ float bfhi(unsigned u) { return __uint_as_float(u & 0xFFFF0000u); }
__device__ __forceinline__ int opaque_tid() { int t = threadIdx.x; asm volatile("" : "+v"(t)); return t; }
__device__ __forceinline__ float silu(float x) { return x / (1.0f + __expf(-x)); }

namespace pg8 {
constexpr int BM = 256, BK = 64, HALF = 128, HTB = HALF * BK * 2, STAGE_BYTES = 8 * HTB, NXCD = 8, WGM = 8;
__device__ __forceinline__ int lds_byte(int r, int c) { const int st = (r >> 4) * 2 + (c >> 5), rr = r & 15, cc = c & 31, ob = rr * 64 + cc * 2; return st * 1024 + (ob ^ (((ob >> 9) & 1) << 5)); }
__device__ __forceinline__ void stage_rc(int b, int& R, int& C) { const int st = b / 1024, sb = b % 1024, swz = sb ^ (((sb >> 9) & 1) << 5); R = (st >> 1) * 16 + swz / 64; C = (st & 1) * 32 + (swz % 64) / 2; }
struct Unit { int pm, pn; };
struct Gemm { const bf16_t* A; const bf16_t* Bt; int K; };

struct Order {
    int nM, nN, nwg, G, c, i0, Loff, pm_add, pn_skip_from, pn_skip_by;
    __device__ bool next(int i, Unit& u) const {
        const long L = (long)(i + i0) * G + c - Loff; if (L < 0 || L >= nwg) return false;
        int wgid = (int)L; { const int q = nwg / NXCD, r = nwg % NXCD, xcd = wgid % NXCD, off = wgid / NXCD; wgid = (xcd < r ? xcd * (q + 1) : r * (q + 1) + (xcd - r) * q) + off; }
        const int nig = WGM * nN, gid = wgid / nig, fm = gid * WGM, gsz = (nM - fm) < WGM ? (nM - fm) : WGM;
        u.pm = fm + ((wgid % nig) % gsz) + pm_add; int pn = (wgid % nig) / gsz; if (pn >= pn_skip_from) pn += pn_skip_by; u.pn = pn; return true;
    }
};

template <class Epi>
__device__ __forceinline__ void gemm_phase(LAS unsigned char* lds, const Gemm g, const Order& S, const Epi& E) {
    const int tid = opaque_tid(), wid = __builtin_amdgcn_readfirstlane(tid >> 6), lane = tid & 63, wr = wid >> 2, wc = wid & 3, fr = lane & 15, fq = lane >> 4;
    const int K = g.K, nt = K / BK;
    unsigned voffA[2], voffB[2];
#pragma unroll
    for (int i = 0; i < 2; ++i) { int R, C; stage_rc(tid * 16 + i * 8192, R, C); const int Rb = Epi::BPERM ? (64 * (R >> 5) + 16 * ((R >> 2) & 3) + 4 * ((R >> 4) & 1) + (R & 3)) : R;
        voffA[i] = (unsigned)(R * K + C) * 2u; voffB[i] = (unsigned)(Rb * K + C) * 2u; }
    const size_t kstep = (size_t)(BK * 2);
    const size_t hstep = (size_t)HALF * K * 2;
    const size_t hstepB = Epi::BPERM ? (size_t)8 * K * 2 : hstep;
    const size_t tstep = 2 * hstep;
    const unsigned ldsw = (unsigned)wid * 1024u;
    const int aoff = lds_byte(wr * 64 + fr, fq * 8), boff = lds_byte(wc * 32 + fr, fq * 8);
#define PG8_SA(b, h) (((b) * 2 + (h)) * HTB)
#define PG8_SB(b, h) ((4 + (b) * 2 + (h)) * HTB)
#define PG8_STAGE(bufoff, gbase, voff) do { _Pragma("unroll") for (int _i = 0; _i < 2; ++_i) \
        __builtin_amdgcn_global_load_lds((const unsigned*)((const char*)(gbase) + (voff)[_i]), (LAS unsigned*)(lds + (bufoff) + ldsw + _i * 8192), 16, 0, 0); } while (0)
#define PG8_LDA(dst, b, h) do { _Pragma("unroll") for (int m = 0; m < 4; ++m) _Pragma("unroll") for (int k = 0; k < 2; ++k) dst[m][k] = *(const LAS bf16x8*)(lds + PG8_SA(b, h) + aoff + m * 2048 + k * 1024); } while (0)
#define PG8_LDB(dst, b, h) do { _Pragma("unroll") for (int n = 0; n < 2; ++n) _Pragma("unroll") for (int k = 0; k < 2; ++k) dst[n][k] = *(const LAS bf16x8*)(lds + PG8_SB(b, h) + boff + n * 2048 + k * 1024); } while (0)
#define PG8_MMA(ai, bj, At, Bt) do { __builtin_amdgcn_s_setprio(1); _Pragma("unroll") for (int m = 0; m < 4; ++m) _Pragma("unroll") for (int n = 0; n < 2; ++n) _Pragma("unroll") for (int k = 0; k < 2; ++k) \
        acc[ai][bj][m][n] = __builtin_amdgcn_mfma_f32_16x16x32_bf16(Bt[n][k], At[m][k], acc[ai][bj][m][n], 0, 0, 0); __builtin_amdgcn_s_setprio(0); } while (0)
#define PG8_WAIT_V(n) asm volatile("s_waitcnt vmcnt(" #n ")" ::: "memory")
#define PG8_WAIT_L(n) asm volatile("s_waitcnt lgkmcnt(" #n ")" ::: "memory")
#define PG8_BAR __builtin_amdgcn_s_barrier()
#define PG8_SCHED __builtin_amdgcn_sched_barrier(0)
    Unit cur, nxt; int ui = 0;
    if (!S.next(0, cur)) return;
    f32x4 acc[2][2][4][2];
#pragma unroll
    for (int a = 0; a < 2; ++a)
#pragma unroll
        for (int b = 0; b < 2; ++b)
#pragma unroll
            for (int m = 0; m < 4; ++m)
#pragma unroll
                for (int n = 0; n < 2; ++n) acc[a][b][m][n] = (f32x4){0.f, 0.f, 0.f, 0.f};
    bf16x8 At[4][2], B0[2][2], B1[2][2];
    const char* cA = (const char*)g.A + (size_t)cur.pm * tstep; const char* cB = (const char*)g.Bt + (size_t)cur.pn * tstep;
    PG8_STAGE(PG8_SB(0, 0), cB, voffB); PG8_STAGE(PG8_SA(0, 0), cA, voffA); PG8_STAGE(PG8_SB(0, 1), cB + hstepB, voffB); PG8_STAGE(PG8_SA(0, 1), cA + hstep, voffA);
    if (wr == 1) PG8_BAR;
    PG8_WAIT_V(4); PG8_BAR;
    PG8_STAGE(PG8_SB(1, 0), cB + kstep, voffB); PG8_STAGE(PG8_SA(1, 0), cA + kstep, voffA); PG8_STAGE(PG8_SB(1, 1), cB + hstepB + kstep, voffB);
    PG8_WAIT_V(6); PG8_BAR;
    for (;;) {
        const bool has_next = S.next(ui + 1, nxt);
        const char* nA = has_next ? (const char*)g.A + (size_t)nxt.pm * tstep : cA; const char* nB = has_next ? (const char*)g.Bt + (size_t)nxt.pn * tstep : cB;
        for (int t = 0; t < nt; t += 2) {
            const bool last = (t == nt - 2);
            const char* a1 = cA + (size_t)(t + 1) * kstep;
            const char* a2 = last ? nA : cA + (size_t)(t + 2) * kstep; const char* b2 = last ? nB : cB + (size_t)(t + 2) * kstep;
            const char* a3 = a2 + kstep; const char* b3 = b2 + kstep;
            PG8_LDB(B0, 0, 0); PG8_SCHED; PG8_LDA(At, 0, 0); PG8_STAGE(PG8_SA(1, 1), a1 + hstep, voffA);
            PG8_WAIT_L(8); PG8_BAR; PG8_WAIT_L(0); PG8_MMA(0, 0, At, B0); PG8_BAR; PG8_SCHED;
            PG8_LDB(B1, 0, 1); PG8_STAGE(PG8_SB(0, 0), b2, voffB);
            PG8_BAR; PG8_WAIT_L(0); PG8_MMA(0, 1, At, B1); PG8_BAR;
            PG8_LDA(At, 0, 1); PG8_STAGE(PG8_SA(0, 0), a2, voffA);
            PG8_BAR; PG8_WAIT_L(0); PG8_MMA(1, 0, At, B0); PG8_BAR; PG8_SCHED;
            PG8_STAGE(PG8_SB(0, 1), b2 + hstepB, voffB);
            PG8_WAIT_V(6); PG8_BAR; PG8_MMA(1, 1, At, B1); PG8_BAR;
            PG8_LDB(B0, 1, 0); PG8_SCHED; PG8_LDA(At, 1, 0); PG8_STAGE(PG8_SA(0, 1), a2 + hstep, voffA);
            PG8_WAIT_L(8); PG8_BAR; PG8_WAIT_L(0); PG8_MMA(0, 0, At, B0); PG8_BAR; PG8_SCHED;
            PG8_LDB(B1, 1, 1); PG8_STAGE(PG8_SB(1, 0), b3, voffB);
            PG8_BAR; PG8_WAIT_L(0); PG8_MMA(0, 1, At, B1); PG8_BAR;
            PG8_LDA(At, 1, 1); PG8_STAGE(PG8_SA(1, 0), a3, voffA);
            PG8_BAR; PG8_WAIT_L(0); PG8_MMA(1, 0, At, B0); PG8_BAR; PG8_SCHED;
            PG8_STAGE(PG8_SB(1, 1), b3 + hstepB, voffB);
            PG8_WAIT_V(6); PG8_BAR; PG8_MMA(1, 1, At, B1); PG8_BAR;
        }
        E(acc, cur, wr, wc, fr, fq);
        if (!has_next) break;
#pragma unroll
        for (int a = 0; a < 2; ++a)
#pragma unroll
            for (int b = 0; b < 2; ++b)
#pragma unroll
                for (int m = 0; m < 4; ++m)
#pragma unroll
                    for (int n = 0; n < 2; ++n) acc[a][b][m][n] = (f32x4){0.f, 0.f, 0.f, 0.f};
        cur = nxt; cA = nA; cB = nB; ++ui;
    }
    PG8_WAIT_V(0);
    if (wr == 0) PG8_BAR;
    PG8_BAR;
#undef PG8_SA
#undef PG8_SB
#undef PG8_STAGE
#undef PG8_LDA
#undef PG8_LDB
#undef PG8_MMA
#undef PG8_WAIT_V
#undef PG8_WAIT_L
#undef PG8_BAR
#undef PG8_SCHED
}
}
using pg8::Unit;

__device__ __forceinline__ unsigned cvt_pk_bf16(float lo, float hi) { unsigned r; asm("v_cvt_pk_bf16_f32 %0, %1, %2" : "=v"(r) : "v"(lo), "v"(hi)); return r; }

struct EpiIn {
    static constexpr bool BPERM = true;
    bf16_t* P; bf16_t* KF; const float* qg; const float* kg; float* outk_p; float* outk_s;
    __device__ __forceinline__ void operator()(const f32x4 (&acc)[2][2][4][2], const Unit& u, int wr, int wc, int fr, int fq) const {
        const int pn = u.pn;
        const int kind = (pn >= 3 && pn < 6) ? 1 : ((pn >= 6 && pn < 9) ? 2 : 0);
        const int col0 = pn * 256 + wc * 64 + 16 * fq;
        f32x4 gv[2][2];
        const float* gp = kind == 1 ? qg : kg;
#pragma unroll
        for (int bj = 0; bj < 2; ++bj)
#pragma unroll
            for (int n = 0; n < 2; ++n) {
                if (kind) { gv[bj][n] = *(const f32x4*)(gp + 16 * fq + 8 * bj + 4 * n); if (kind == 1) gv[bj][n] = gv[bj][n] * (0.125f * LOG2E); }
                else gv[bj][n] = (f32x4){1.f, 1.f, 1.f, 1.f};
            }
#pragma unroll
        for (int ai = 0; ai < 2; ++ai)
#pragma unroll
            for (int m = 0; m < 4; ++m) {
                const int r = u.pm * 256 + ai * 128 + wr * 64 + m * 16 + fr;
                float rstd = 1.0f;
                if (kind) {
                    float ss = 0.f;
#pragma unroll
                    for (int bj = 0; bj < 2; ++bj)
#pragma unroll
                        for (int n = 0; n < 2; ++n)
#pragma unroll
                            for (int e = 0; e < 4; ++e) ss += acc[ai][bj][m][n][e] * acc[ai][bj][m][n][e];
                    ss += __shfl_xor(ss, 16); ss += __shfl_xor(ss, 32);
                    rstd = rsqrtf(ss * (1.0f / 64.0f) + 1e-6f);
                }
                f32x4 v[2][2];
#pragma unroll
                for (int bj = 0; bj < 2; ++bj)
#pragma unroll
                    for (int n = 0; n < 2; ++n) v[bj][n] = acc[ai][bj][m][n] * gv[bj][n] * rstd;
                if (r < TTOK) {
                    u32x4 o0, o1;
                    o0[0] = cvt_pk_bf16(v[0][0][0], v[0][0][1]); o0[1] = cvt_pk_bf16(v[0][0][2], v[0][0][3]); o0[2] = cvt_pk_bf16(v[0][1][0], v[0][1][1]); o0[3] = cvt_pk_bf16(v[0][1][2], v[0][1][3]);
                    o1[0] = cvt_pk_bf16(v[1][0][0], v[1][0][1]); o1[1] = cvt_pk_bf16(v[1][0][2], v[1][0][3]); o1[2] = cvt_pk_bf16(v[1][1][0], v[1][1][1]); o1[3] = cvt_pk_bf16(v[1][1][2], v[1][1][3]);
                    if (kind != 2) { bf16_t* dst = P + (size_t)r * PROJ + col0; *(u32x4*)dst = o0; *(u32x4*)(dst + 8) = o1; }
                    else if (r < SEQ) {
                        const int hk = (pn - 6) * 4 + wc;
#pragma unroll
                        for (int pat = 0; pat < 3; ++pat) {
                            const int ldil = 2 * pat, sidx = r >> ldil, res = r & ((1 << ldil) - 1);
                            bf16_t* dst = KF + (size_t)pat * ((size_t)768 * SEQ) + (size_t)(hk * 512 + res * (512 >> ldil) + (sidx >> 5)) * 2048 + fq * 512 + (sidx & 31) * 8;
                            *(u32x4*)dst = o0; *(u32x4*)(dst + 256) = o1;
                        }
                    }
                    if (kind == 2 && r >= SEQ - CACHE) {
                        float* od = r < SEQ ? outk_p + (size_t)(r - (SEQ - CACHE)) * 768 + (col0 - 1536) : outk_s + (size_t)(r - SEQ) * 768 + (col0 - 1536);
                        *(f32x4*)(od) = v[0][0]; *(f32x4*)(od + 4) = v[0][1]; *(f32x4*)(od + 8) = v[1][0]; *(f32x4*)(od + 12) = v[1][1];
                    }
                }
            }
    }
};
struct EpiV {
    static constexpr bool BPERM = true;
    bf16_t *VT1, *VT2, *VT3; float* outv_p; float* outv_s; LAS unsigned char* xb;
    __device__ __forceinline__ void operator()(const f32x4 (&acc)[2][2][4][2], const Unit& u, int wr, int wc, int fr, int fq) const {
        LAS unsigned char* xw = xb + (wr * 4 + wc) * 2304;
        const int tw = u.pn * 256 + wc * 64;
        const int t0 = tw + 16 * fq;
        const int lane = fr + 16 * fq;
#pragma unroll
        for (int ai = 0; ai < 2; ++ai)
#pragma unroll
            for (int m = 0; m < 4; ++m) {
                const int fbase = u.pm * 256 + ai * 128 + wr * 64 + m * 16 - 2304;
                const int fv = fbase + fr;
                if (tw < SEQ) {
                    u32x4 o0, o1;
                    o0[0] = cvt_pk_bf16(acc[ai][0][m][0][0], acc[ai][0][m][0][1]); o0[1] = cvt_pk_bf16(acc[ai][0][m][0][2], acc[ai][0][m][0][3]);
                    o0[2] = cvt_pk_bf16(acc[ai][0][m][1][0], acc[ai][0][m][1][1]); o0[3] = cvt_pk_bf16(acc[ai][0][m][1][2], acc[ai][0][m][1][3]);
                    o1[0] = cvt_pk_bf16(acc[ai][1][m][0][0], acc[ai][1][m][0][1]); o1[1] = cvt_pk_bf16(acc[ai][1][m][0][2], acc[ai][1][m][0][3]);
                    o1[2] = cvt_pk_bf16(acc[ai][1][m][1][0], acc[ai][1][m][1][1]); o1[3] = cvt_pk_bf16(acc[ai][1][m][1][2], acc[ai][1][m][1][3]);
                    const int hv = fv >> 6, dv = fv & 63, fo = (dv >> 5) * 1024 + (dv & 31) * 8;
                    {
                        u32x4 p0, p1; p0[0] = o0[0]; p0[1] = o0[1]; p0[2] = o1[0]; p0[3] = o1[1]; p1[0] = o0[2]; p1[1] = o0[3]; p1[2] = o1[2]; p1[3] = o1[3];
                        bf16_t* d1 = VT1 + (size_t)(hv * 512 + (t0 >> 5)) * 2048 + ((t0 >> 4) & 1) * 512 + fo;
                        *(u32x4*)d1 = p0; *(u32x4*)(d1 + 256) = p1;
                    }
#pragma unroll
                    for (int e = 0; e < 4; ++e) {
                        u32x2 w2; w2[0] = cvt_pk_bf16(acc[ai][0][m][0][e], acc[ai][0][m][1][e]); w2[1] = cvt_pk_bf16(acc[ai][1][m][0][e], acc[ai][1][m][1][e]);
                        const int si = t0 >> 2, qq = (si >> 2) & 3;
                        *(u32x2*)(VT2 + (size_t)(hv * 512 + e * 128 + (si >> 5)) * 2048 + ((si >> 4) & 1) * 512 + fo + (qq & 1) * 256 + (qq >> 1) * 4) = w2;
                    }
                    *(LAS u32x4*)(xw + fr * 144 + fq * 32) = o0; *(LAS u32x4*)(xw + fr * 144 + fq * 32 + 16) = o1;
#pragma unroll
                    for (int k = 0; k < 4; ++k) {
                        const int id = lane + 64 * k, f2 = id & 15, rho = id >> 4;
                        const LAS unsigned short* srcp = (const LAS unsigned short*)(xw + f2 * 144 + rho * 2);
                        const unsigned a0 = srcp[0], a1 = srcp[16], a2 = srcp[32], a3 = srcp[48];
                        u32x2 w3; w3[0] = a0 | (a1 << 16); w3[1] = a2 | (a3 << 16);
                        const int fv2 = fbase + f2, h2 = fv2 >> 6, d2 = fv2 & 63, si = tw >> 4, qq = (si >> 2) & 3;
                        *(u32x2*)(VT3 + (size_t)(h2 * 512 + rho * 32 + (si >> 5)) * 2048 + ((si >> 4) & 1) * 512 + (d2 >> 5) * 1024 + (d2 & 31) * 8 + (qq & 1) * 256 + (qq >> 1) * 4) = w3;
                    }
                    if (tw >= SEQ - CACHE) {
#pragma unroll
                        for (int bj = 0; bj < 2; ++bj)
#pragma unroll
                            for (int n = 0; n < 2; ++n)
#pragma unroll
                                for (int e = 0; e < 4; ++e) outv_p[(size_t)(t0 + 8 * bj + 4 * n + e - (SEQ - CACHE)) * 768 + fv] = acc[ai][bj][m][n][e];
                    }
                } else if (t0 < TTOK) {
#pragma unroll
                    for (int bj = 0; bj < 2; ++bj)
#pragma unroll
                        for (int n = 0; n < 2; ++n)
#pragma unroll
                            for (int e = 0; e < 4; ++e) outv_s[(size_t)(t0 + 8 * bj + 4 * n + e - SEQ) * 768 + fv] = acc[ai][bj][m][n][e];
                }
            }
    }
};
struct EpiOut {
    static constexpr bool BPERM = true;
    const float* xin; float* xo;
    __device__ __forceinline__ void operator()(const f32x4 (&acc)[2][2][4][2], const Unit& u, int wr, int wc, int fr, int fq) const {
        const int c0 = u.pn * 256 + wc * 64 + 16 * fq;
#pragma unroll
        for (int ai = 0; ai < 2; ++ai)
#pragma unroll
            for (int m = 0; m < 4; ++m) {
                const int r = u.pm * 256 + ai * 128 + wr * 64 + m * 16 + fr;
                const float* xi = xin + (size_t)r * 1024 + c0; float* xop = xo + (size_t)r * 1024 + c0;
                f32x4 x[2][2];
#pragma unroll
                for (int bj = 0; bj < 2; ++bj)
#pragma unroll
                    for (int n = 0; n < 2; ++n) x[bj][n] = *(const f32x4*)(xi + 8 * bj + 4 * n);
#pragma unroll
                for (int bj = 0; bj < 2; ++bj)
#pragma unroll
                    for (int n = 0; n < 2; ++n) *(f32x4*)(xop + 8 * bj + 4 * n) = x[bj][n] + acc[ai][bj][m][n];
            }
    }
};
__device__ void sample_outproj(const Params& p, int layer) {
    const int tid = opaque_tid(), dotid = tid >> 2, sub = tid & 3, row = dotid >> 2;
    const float* xi = layer == 0 ? p.x_sample : WSP(p, float, WS_X1) + (size_t)SEQ * 1024;
    float* xo = layer == 0 ? WSP(p, float, WS_X1) + (size_t)SEQ * 1024 : p.out + O_YS;
    for (int cb = blockIdx.x; cb < 256; cb += gridDim.x) {
        const int col = 4 * cb + (dotid & 3);
        const bf16_t* gp = WSP(p, bf16_t, WS_G) + (size_t)(SEQ + row) * 1024 + sub * 256;
        const bf16_t* wp = WSP(p, bf16_t, WS_WOUTT) + (size_t)layer * 1024 * 1024 + (size_t)col * 1024 + sub * 256;
        float a = 0.f;
#pragma unroll 8
        for (int i = 0; i < 32; ++i) {
            const u32x4 gv = *(const u32x4*)(gp + 8 * i), wv = *(const u32x4*)(wp + 8 * i);
#pragma unroll
            for (int j = 0; j < 4; ++j) a += bflo(gv[j]) * bflo(wv[j]) + bfhi(gv[j]) * bfhi(wv[j]);
        }
        a += __shfl_xor(a, 1); a += __shfl_xor(a, 2);
        if (sub == 0) xo[(size_t)row * 1024 + col] = xi[(size_t)row * 1024 + col] + a;
    }
}
__device__ void transpose_tile(const float* __restrict__ src, bf16_t* __restrict__ dst, int K, int N, int tile_id, float* tile) {
    const int tilesN = N / 64, kb = (tile_id / tilesN) * 64, nb = (tile_id % tilesN) * 64, tid = opaque_tid();
    { const int n = tid & 63, k0 = tid >> 6;
#pragma unroll
      for (int i = 0; i < 8; ++i) { const int k = k0 + 8 * i; tile[k * 65 + n] = src[(size_t)(kb + k) * N + nb + n]; } }
    __syncthreads();
    { const int k = tid & 63, n0 = tid >> 6;
#pragma unroll
      for (int i = 0; i < 8; ++i) { const int n = n0 + 8 * i; dst[(size_t)(nb + n) * K + kb + k] = f2bf(tile[k * 65 + n]); } }
    __syncthreads();
}

__device__ void rmsnorm_rows(const Params& p, int layer) {
    const int tid = opaque_tid(), lane = tid & 63, wg = blockIdx.x * 8 + (tid >> 6), nw = gridDim.x * 8;
    const float* g = p.norm_g + layer * 1024;
    for (int row = wg; row < TTOK; row += nw) {
        const float* src = layer == 0 ? (row < SEQ ? p.x_prompt + (size_t)row * 1024 : p.x_sample + (size_t)(row - SEQ) * 1024) : WSP(p, float, WS_X1) + (size_t)row * 1024;
        f32x4 v[4]; float ss = 0.f;
#pragma unroll
        for (int i = 0; i < 4; ++i) { v[i] = *(const f32x4*)(src + i * 256 + lane * 4); ss += v[i][0] * v[i][0] + v[i][1] * v[i][1] + v[i][2] * v[i][2] + v[i][3] * v[i][3]; }
#pragma unroll
        for (int o = 32; o >= 1; o >>= 1) ss += __shfl_xor(ss, o);
        const float rstd = rsqrtf(ss * (1.0f / 1024.0f) + 1e-6f);
#pragma unroll
        for (int i = 0; i < 4; ++i) { const f32x4 gv = *(const f32x4*)(g + i * 256 + lane * 4); const f32x4 y = v[i] * rstd * gv;
            u32x2 o; o[0] = pk2(y[0], y[1]); o[1] = pk2(y[2], y[3]); *(u32x2*)(WSP(p, bf16_t, WS_HB) + (size_t)row * 1024 + i * 256 + lane * 4) = o; }
    }
}

struct KVf { bf16x8 k[4]; bf16x8 v[2][2]; };
struct TileGeom { int pat, tt, kt, qb, ldil; };
__device__ __forceinline__ TileGeom tile_geom(int it, int w) {
    TileGeom g; g.pat = it >= 20 ? 2 : (it >= 10 ? 1 : 0); const int rem = it - 10 * g.pat; g.tt = rem >= 5 ? 1 : 0; g.kt = rem - 5 * g.tt;
    const int tl = w + 8 * g.tt; g.qb = g.pat == 0 ? 32 * tl : (g.pat == 1 ? 128 * (tl >> 2) + (tl & 3) : tl); g.ldil = 2 * g.pat; return g;
}
__device__ __forceinline__ void load_kv(KVf& f, const bf16_t* __restrict__ kfh  , const bf16_t* __restrict__ vfh  , int it, int w, int T0) {
    const TileGeom g = tile_geom(it, w);
    const int dil = 1 << g.ldil, qbase = T0 + g.qb, vidx0 = qbase >> g.ldil, res = qbase & (dil - 1), kk0 = -128 + 32 * g.kt;
    int tile = (vidx0 + kk0) >> 5; tile = tile < 0 ? 0 : tile;
    const size_t off = (size_t)g.pat * ((size_t)768 * SEQ) + (size_t)(res * (512 >> g.ldil) + tile) * 2048;
    const bf16_t* kp = kfh + off; const bf16_t* vp = vfh + off;
#pragma unroll
    for (int s = 0; s < 4; ++s) f.k[s] = *(const bf16x8*)(kp + 512 * s);
#pragma unroll
    for (int mt = 0; mt < 2; ++mt)
#pragma unroll
        for (int s2 = 0; s2 < 2; ++s2) f.v[mt][s2] = *(const bf16x8*)(vp + (mt * 2 + s2) * 512);
}
template <bool MASK>
__device__ __forceinline__ void attn_tile(const KVf& f, const bf16x8 (&qf)[4], f32x16& O0, f32x16& O1, float& den, float dsl, float base, int kk0, int vidx0, int c, int hh) {
    f32x16 S;
#pragma unroll
    for (int r = 0; r < 16; ++r) S[r] = fmaf(dsl, (float)((r & 3) + 8 * (r >> 2)), base);
#pragma unroll
    for (int s = 0; s < 4; ++s) S = __builtin_amdgcn_mfma_f32_32x32x16_bf16(f.k[s], qf[s], S, 0, 0, 0);
#pragma unroll
    for (int r = 0; r < 16; ++r) {
        float pv = __builtin_amdgcn_exp2f(S[r]);
        if (MASK) { const int kk = kk0 + (r & 3) + 8 * (r >> 2) + 4 * hh; const int dd = c - kk; const bool valid = (dd >= 0) && (dd <= 128) && (vidx0 + kk >= 0); pv = valid ? pv : 0.f; }
        den += pv; S[r] = pv;
    }
#pragma unroll
    for (int s2 = 0; s2 < 2; ++s2) {
        u32x4 pw;
#pragma unroll
        for (int j = 0; j < 4; ++j) pw[j] = cvt_pk_bf16(S[8 * s2 + 2 * j], S[8 * s2 + 2 * j + 1]);
        const bf16x8 pf = __builtin_bit_cast(bf16x8, pw);
        O0 = __builtin_amdgcn_mfma_f32_32x32x16_bf16(f.v[0][s2], pf, O0, 0, 0, 0);
        O1 = __builtin_amdgcn_mfma_f32_32x32x16_bf16(f.v[1][s2], pf, O1, 0, 0, 0);
    }
}

__device__ void attn_item(const Params& p, int layer, int sb, int h, float* accL, float Mref2) {
    const int tid = opaque_tid(), w = tid >> 6, lane = tid & 63, c = lane & 31, hh = lane >> 5;
    const int T0 = sb * 512;
    const float sl2 = exp2f(-8.0f * (float)(h + 1) / 12.0f) * LOG2E;
    const bf16_t* __restrict__ P = WSP(p, bf16_t, WS_P);
    const bf16_t* __restrict__ qbasep = P + 768 + h * 64 + 8 * hh;
    const bf16_t* __restrict__ kfh = WSP(p, bf16_t, WS_KF) + (size_t)h * (512 * 2048) + lane * 8;
    const bf16_t* __restrict__ vfh = WSP(p, bf16_t, WS_VT1) + (size_t)h * (512 * 2048) + lane * 8;
    KVf f0, f1, f2;
    bf16x8 qf[4];
    f32x16 O0, O1; float den = 0.f;
#pragma unroll
    for (int r = 0; r < 16; ++r) { O0[r] = 0.f; O1[r] = 0.f; }
    { const TileGeom g = tile_geom(0, w); const bf16_t* qp = qbasep + (size_t)(T0 + g.qb + (c << g.ldil)) * PROJ;
#pragma unroll
      for (int s = 0; s < 4; ++s) qf[s] = *(const bf16x8*)(qp + 16 * s); }
    load_kv(f0, kfh, vfh, 0, w, T0);
    load_kv(f1, kfh, vfh, 1, w, T0);
#define ATTN_STEP(FA, FC, IT) { \
        const int it_ = (IT); \
        if (it_ + 2 < 30) load_kv(FC, kfh, vfh, it_ + 2, w, T0); \
        const TileGeom g = tile_geom(it_, w); \
        const int dil = 1 << g.ldil, qbase = T0 + g.qb, vidx0 = qbase >> g.ldil, kk0 = -128 + 32 * g.kt; \
        if (g.kt == 0) { _Pragma("unroll") for (int r = 0; r < 16; ++r) { O0[r] = 0.f; O1[r] = 0.f; } den = 0.f; } \
        const float dsl = sl2 * (float)dil; \
        const float base = dsl * (float)(kk0 - c + 4 * hh) - Mref2; \
        if (g.kt == 0 || g.kt == 4 || vidx0 < 128) attn_tile<true>(FA, qf, O0, O1, den, dsl, base, kk0, vidx0, c, hh); \
        else attn_tile<false>(FA, qf, O0, O1, den, dsl, base, kk0, vidx0, c, hh); \
        if (g.kt == 4) { \
            if (it_ + 1 < 30) { const TileGeom gn = tile_geom(it_ + 1, w); const bf16_t* qp = qbasep + (size_t)(T0 + gn.qb + (c << gn.ldil)) * PROJ; \
                _Pragma("unroll") for (int s = 0; s < 4; ++s) qf[s] = *(const bf16x8*)(qp + 16 * s); } \
            const float dt = den + __shfl_xor(den, 32); \
            float* arow = accL + (g.qb + (c << g.ldil)) * 65; \
            if (g.pat == 0) { \
                _Pragma("unroll") for (int r = 0; r < 16; ++r) { const int d = (r & 3) + 8 * (r >> 2) + 4 * hh; arow[d] = O0[r]; arow[32 + d] = O1[r]; } \
                if (hh == 0) arow[64] = dt; \
            } else { \
                _Pragma("unroll") for (int r = 0; r < 16; ++r) { const int d = (r & 3) + 8 * (r >> 2) + 4 * hh; arow[d] += O0[r]; arow[32 + d] += O1[r]; } \
                if (hh == 0) arow[64] += dt; \
            } \
            if (g.tt == 1) __syncthreads(); \
        } }
#pragma unroll 1
    for (int it = 0; it < 30; it += 3) {
        ATTN_STEP(f0, f2, it);
        ATTN_STEP(f1, f0, it + 1);
        ATTN_STEP(f2, f1, it + 2);
    }
#undef ATTN_STEP
    bf16_t* __restrict__ Gp = WSP(p, bf16_t, WS_G);
#pragma unroll 1
    for (int it = 0; it < 4; ++it) {
        unsigned zb[8];
#pragma unroll
        for (int j = 0; j < 8; ++j) { const int idx = tid + NTHREADS * (it * 8 + j); const int ql = idx >> 5, d2 = (idx & 31) * 2;
            zb[j] = *(const unsigned*)(P + (size_t)(T0 + ql) * PROJ + 3072 + h * 64 + d2); }
#pragma unroll
        for (int j = 0; j < 8; ++j) { const int idx = tid + NTHREADS * (it * 8 + j); const int ql = idx >> 5, d2 = (idx & 31) * 2;
            const float inv = 1.0f / accL[ql * 65 + 64];
            const float o0 = accL[ql * 65 + d2] * inv * silu(bflo(zb[j])), o1 = accL[ql * 65 + d2 + 1] * inv * silu(bfhi(zb[j]));
            *(unsigned*)(Gp + (size_t)(T0 + ql) * 1024 + 256 + h * 64 + d2) = cvt_pk_bf16(o0, o1); }
    }
    __syncthreads();
}

__device__ void sgu_item(const Params& p, int layer, int ch, int g, bf16_t* vnT  ) {
    const int tid = opaque_tid(), w = tid >> 6, lane = tid & 63, c = lane & 31, hh = lane >> 5;
    const int R0 = ch * 128;
    const bf16_t* __restrict__ P = WSP(p, bf16_t, WS_P);
    const float* sg = p.sgu_g + layer * 256;
    const int tt = w >> 1, dt = w & 1;
    const int t = 32 * tt + c;
    const float* wrow = p.w_sp + ((size_t)(layer * 4 + g) * 128 + t) * 128 + 8 * hh;
    u32x2 vv[16];
#pragma unroll
    for (int rr = 0; rr < 16; ++rr) vv[rr] = *(const u32x2*)(P + (size_t)(R0 + w * 16 + rr) * PROJ + 256 + lane * 4);
    f32x4 w0[8], w1[8];
#pragma unroll
    for (int ks = 0; ks < 8; ++ks) { if (ks <= 2 * tt + 1) { w0[ks] = *(const f32x4*)(wrow + 16 * ks); w1[ks] = *(const f32x4*)(wrow + 16 * ks + 4); } else { w0[ks] = (f32x4){0.f, 0.f, 0.f, 0.f}; w1[ks] = w0[ks]; } }
    const f32x4 gv = *(const f32x4*)(sg + g * 64 + (lane & 15) * 4);
#pragma unroll
    for (int rr = 0; rr < 16; ++rr) {
        const int row = w * 16 + rr;
        const float f0 = bflo(vv[rr][0]), f1 = bfhi(vv[rr][0]), f2 = bflo(vv[rr][1]), f3 = bfhi(vv[rr][1]);
        float ss = f0 * f0 + f1 * f1 + f2 * f2 + f3 * f3;
#pragma unroll
        for (int o = 32; o >= 1; o >>= 1) ss += __shfl_xor(ss, o);
        const float rstd = rsqrtf(ss * (1.0f / 256.0f) + 1e-6f);
        if ((lane >> 4) == g) {
            const int dl = (lane & 15) * 4;
            vnT[(dl + 0) * 136 + row] = f2bf(f0 * rstd * gv[0]); vnT[(dl + 1) * 136 + row] = f2bf(f1 * rstd * gv[1]);
            vnT[(dl + 2) * 136 + row] = f2bf(f2 * rstd * gv[2]); vnT[(dl + 3) * 136 + row] = f2bf(f3 * rstd * gv[3]);
        }
    }
    const float* bsp = p.b_sp + (size_t)(layer * 4 + g) * 128;
    const int colA = g * 64 + 32 * dt + c;
    bf16_t uav[16], zav[16]; float bv[16];
#pragma unroll
    for (int r = 0; r < 16; ++r) { const int tr = 32 * tt + (r & 3) + 8 * (r >> 2) + 4 * hh; const size_t row = (size_t)(R0 + tr);
        uav[r] = P[row * PROJ + colA]; zav[r] = P[row * PROJ + 512 + colA]; bv[r] = bsp[tr]; }
    __syncthreads();
    f32x16 acc;
#pragma unroll
    for (int r = 0; r < 16; ++r) acc[r] = 0.f;
#pragma unroll
    for (int ks = 0; ks < 8; ++ks) {
        if (ks <= 2 * tt + 1) {
            const int s0 = 16 * ks + 8 * hh;
            u32x4 aw;
            aw[0] = cvt_pk_bf16(s0 + 0 <= t ? w0[ks][0] : 0.f, s0 + 1 <= t ? w0[ks][1] : 0.f); aw[1] = cvt_pk_bf16(s0 + 2 <= t ? w0[ks][2] : 0.f, s0 + 3 <= t ? w0[ks][3] : 0.f);
            aw[2] = cvt_pk_bf16(s0 + 4 <= t ? w1[ks][0] : 0.f, s0 + 5 <= t ? w1[ks][1] : 0.f); aw[3] = cvt_pk_bf16(s0 + 6 <= t ? w1[ks][2] : 0.f, s0 + 7 <= t ? w1[ks][3] : 0.f);
            const bf16x8 bfrag = *(const bf16x8*)(vnT + (32 * dt + c) * 136 + s0);
            acc = __builtin_amdgcn_mfma_f32_32x32x16_bf16(__builtin_bit_cast(bf16x8, aw), bfrag, acc, 0, 0, 0);
        }
    }
    bf16_t* __restrict__ Gp = WSP(p, bf16_t, WS_G);
#pragma unroll
    for (int r = 0; r < 16; ++r) {
        const int tr = 32 * tt + (r & 3) + 8 * (r >> 2) + 4 * hh;
        Gp[(size_t)(R0 + tr) * 1024 + colA] = f2bf(bf2f(uav[r]) * (acc[r] + bv[r]) * silu(bf2f(zav[r])));
    }
    __syncthreads();
}

__device__ void sattn_item(const Params& p, int layer, int b, int h, float* part  , float Mref) {
    const int tid = opaque_tid();
    const float slope = exp2f(-8.0f * (float)(h + 1) / 12.0f);
    const size_t tok = (size_t)(SEQ + b);
    const bf16_t* __restrict__ P = WSP(p, bf16_t, WS_P);
    const float* ck = p.cache_k + ((size_t)(layer * NS + b) * CACHE) * 768 + h * 64;
    const float* cv = p.cache_v + ((size_t)(layer * NS + b) * CACHE) * 768 + h * 64;
    const float* nk = p.out + O_KS + ((size_t)(layer * NS + b)) * 768 + h * 64;
    const float* nv = p.out + O_VS + ((size_t)(layer * NS + b)) * 768 + h * 64;
    const int sub = tid & 15, grp = tid >> 4;
    f32x4 k4[13], v4[13];
#pragma unroll
    for (int it = 0; it < 13; ++it) {
        const int e = it * 32 + grp; const int ee = e < 387 ? e : 0; const int pat = ee >= 258 ? 2 : (ee >= 129 ? 1 : 0); const int j = ee - pat * 129; const int dist = j << (2 * pat);
        const float* kr = dist == 0 ? nk : ck + (size_t)(CACHE - dist) * 768;
        const float* vr = dist == 0 ? nv : cv + (size_t)(CACHE - dist) * 768;
        k4[it] = *(const f32x4*)(kr + sub * 4); v4[it] = *(const f32x4*)(vr + sub * 4);
    }
    f32x4 q4;
    { const u32x2 qv = *(const u32x2*)(P + tok * PROJ + 768 + h * 64 + sub * 4); q4[0] = bflo(qv[0]); q4[1] = bfhi(qv[0]); q4[2] = bflo(qv[1]); q4[3] = bfhi(qv[1]); }
    const float zbv = tid < 64 ? bf2f(P[tok * PROJ + 3072 + h * 64 + tid]) : 0.f;
    f32x4 acc = (f32x4){0.f, 0.f, 0.f, 0.f}; float den = 0.f;
#pragma unroll
    for (int it = 0; it < 13; ++it) {
        const int e = it * 32 + grp; const bool act = e < 387; const int ee = act ? e : 0; const int pat = ee >= 258 ? 2 : (ee >= 129 ? 1 : 0); const int j = ee - pat * 129; const int dist = j << (2 * pat);
        float d = q4[0] * k4[it][0] + q4[1] * k4[it][1] + q4[2] * k4[it][2] + q4[3] * k4[it][3];
        d += __shfl_xor(d, 1); d += __shfl_xor(d, 2); d += __shfl_xor(d, 4); d += __shfl_xor(d, 8);
        const float pe = act ? __builtin_amdgcn_exp2f(d - slope * LOG2E * (float)dist - Mref * LOG2E) : 0.f;
        acc += v4[it] * pe; den += pe;
    }
    *(f32x4*)(part + grp * 68 + sub * 4) = acc; if (sub == 0) part[grp * 68 + 64] = den;
    __syncthreads();
    if (tid < 64) {
        float num = 0.f, dn = 0.f;
#pragma unroll
        for (int k = 0; k < 32; ++k) { num += part[k * 68 + tid]; dn += part[k * 68 + 64]; }
        WSP(p, bf16_t, WS_G)[tok * 1024 + 256 + h * 64 + tid] = f2bf(num / dn * silu(zbv));
    }
    __syncthreads();
}

__device__ void ssgu_item(const Params& p, int layer) {
    const int tid = opaque_tid(), w = tid >> 6, lane = tid & 63;
    const float* sg = p.sgu_g + layer * 256;
    const bf16_t* __restrict__ P = WSP(p, bf16_t, WS_P);
    for (int rr = 0; rr < 4; ++rr) {
        const int b = w * 4 + rr; const size_t tok = (size_t)(SEQ + b);
        const u32x2 v = *(const u32x2*)(P + tok * PROJ + 256 + lane * 4);
        const u32x2 uav = *(const u32x2*)(P + tok * PROJ + lane * 4), zav = *(const u32x2*)(P + tok * PROJ + 512 + lane * 4);
        float f[4] = {bflo(v[0]), bfhi(v[0]), bflo(v[1]), bfhi(v[1])};
        float ss = f[0] * f[0] + f[1] * f[1] + f[2] * f[2] + f[3] * f[3];
#pragma unroll
        for (int o = 32; o >= 1; o >>= 1) ss += __shfl_xor(ss, o);
        const float rstd = rsqrtf(ss * (1.0f / 256.0f) + 1e-6f);
        const int g = lane >> 4;
        const float w00 = p.w_sp[(size_t)(layer * 4 + g) * 128 * 128], b0 = p.b_sp[(size_t)(layer * 4 + g) * 128];
        const float ua[4] = {bflo(uav[0]), bfhi(uav[0]), bflo(uav[1]), bfhi(uav[1])}, za[4] = {bflo(zav[0]), bfhi(zav[0]), bflo(zav[1]), bfhi(zav[1])};
        const f32x4 gv = *(const f32x4*)(sg + lane * 4);
        f32x4 vn; float o[4];
#pragma unroll
        for (int e = 0; e < 4; ++e) { vn[e] = f[e] * rstd * gv[e]; o[e] = ua[e] * (w00 * vn[e] + b0) * silu(za[e]); }
        *(f32x4*)(p.out + O_SG + ((size_t)(layer * NS + b)) * 256 + lane * 4) = vn;
        u32x2 go; go[0] = pk2(o[0], o[1]); go[1] = pk2(o[2], o[3]);
        *(u32x2*)(WSP(p, bf16_t, WS_G) + tok * 1024 + lane * 4) = go;
    }
    __syncthreads();
}

__global__ void __launch_bounds__(NTHREADS, 2) hymba_fwd(Params p) {
    extern __shared__ __attribute__((aligned(16))) unsigned char shm[];
    cg::grid_group grid = cg::this_grid();
    const int G = gridDim.x, c = blockIdx.x;
    for (int ph = p.phase_lo; ph < p.phase_hi; ++ph) {
        if (ph > p.phase_lo) grid.sync();
        const int layer = ph >> 2, kind = ph & 3;
#ifdef DUP_KIND
        for (int rep = 0; rep < ((kind == DUP_KIND) ? 2 : 1); ++rep) {
            if (rep) __syncthreads();
#endif
        if (kind == 0) {
            if (layer == 0) {
                if (c == 0 && threadIdx.x < 8) WSP(p, int, WS_CTL)[threadIdx.x] = 0;
                float* tile = (float*)shm;
                for (int t = c; t < 2432; t += G) {
                    int tt = t; const int l = tt / 1216; tt -= l * 1216;
                    if (tt < 960) transpose_tile(p.w_in + (size_t)l * 1024 * PROJ, WSP(p, bf16_t, WS_WINT) + (size_t)l * PROJ * 1024, 1024, PROJ, tt, tile);
                    else transpose_tile(p.w_out + (size_t)l * 1024 * 1024, WSP(p, bf16_t, WS_WOUTT) + (size_t)l * 1024 * 1024, 1024, 1024, tt - 960, tile);
                }
            }
            rmsnorm_rows(p, layer);
        } else if (kind == 1) {
            LAS unsigned char* lds = (LAS unsigned char*)shm;
            const bf16_t* W = WSP(p, bf16_t, WS_WINT) + (size_t)layer * PROJ * 1024;
            {
                pg8::Order S; S.nM = 65; S.nN = 12; S.nwg = 780; S.G = G; S.c = c; S.i0 = 0; S.Loff = 0; S.pm_add = 0; S.pn_skip_from = 9; S.pn_skip_by = 3;
                pg8::Gemm g; g.A = WSP(p, bf16_t, WS_HB); g.Bt = W; g.K = 1024;
                EpiIn E; E.P = WSP(p, bf16_t, WS_P); E.KF = WSP(p, bf16_t, WS_KF); E.qg = p.qg + layer * 64; E.kg = p.kg + layer * 64; E.outk_p = p.out + O_KP + (size_t)layer * CACHE * 768; E.outk_s = p.out + O_KS + (size_t)layer * NS * 768;
                pg8::gemm_phase<EpiIn>(lds, g, S, E);
            }
            {
                pg8::Order S; S.nM = 3; S.nN = 65; S.nwg = 195; S.G = G; S.c = c; S.i0 = c < 780 ? (780 - c + G - 1) / G : 0; S.Loff = 780; S.pm_add = 9; S.pn_skip_from = 1 << 30; S.pn_skip_by = 0;
                pg8::Gemm g; g.A = W; g.Bt = WSP(p, bf16_t, WS_HB); g.K = 1024;
                EpiV E; E.VT1 = WSP(p, bf16_t, WS_VT1); E.VT2 = WSP(p, bf16_t, WS_VT2); E.VT3 = WSP(p, bf16_t, WS_VT3); E.outv_p = p.out + O_VP + (size_t)layer * CACHE * 768; E.outv_s = p.out + O_VS + (size_t)layer * NS * 768;
                E.xb = lds + LDS_XB;
                pg8::gemm_phase<EpiV>(lds, g, S, E);
            }
        } else if (kind == 2) {
            float gq = 0.f, gk = 0.f;
            for (int i = 0; i < 64; ++i) { gq = fmaxf(gq, fabsf(p.qg[layer * 64 + i])); gk = fmaxf(gk, fabsf(p.kg[layer * 64 + i])); }
            const float Mref = 8.2f * gq * gk;
            int* ctr = WSP(p, int, WS_CTL) + layer
#ifdef DUP_KIND
                + 2 * rep
#endif
                ;
            volatile int* slot = (volatile int*)(shm + LDS_CTL);
            if (threadIdx.x == 0) *slot = atomicAdd(ctr, 1);
            __syncthreads();
            int item = *slot;
            while (item < 1281) {
                __syncthreads();
                int nxt = 0;
                if (threadIdx.x == 0) nxt = atomicAdd(ctr, 1);
#ifdef DUP_ATTN
                if (item < 384) attn_item(p, layer, item / 12, item % 12, (float*)shm, Mref * LOG2E);
#endif
#ifdef DUP_SATTN
                if (item >= 384 && item < 768) sattn_item(p, layer, (item - 384) / 12, (item - 384) % 12, (float*)shm, Mref);
#endif
#ifdef DUP_SGU
                if (item >= 768 && item < 1280) sgu_item(p, layer, (item - 768) >> 2, (item - 768) & 3, (bf16_t*)shm);
#endif
                if (item < 384) attn_item(p, layer, item / 12, item % 12, (float*)shm, Mref * LOG2E);
                else if (item < 768) sattn_item(p, layer, (item - 384) / 12, (item - 384) % 12, (float*)shm, Mref);
                else if (item < 1280) sgu_item(p, layer, (item - 768) >> 2, (item - 768) & 3, (bf16_t*)shm);
                else ssgu_item(p, layer);
                if (threadIdx.x == 0) *slot = nxt;
                __syncthreads();
                item = *slot;
            }
        } else {
            LAS unsigned char* lds = (LAS unsigned char*)shm;
            pg8::Order S; S.nM = 64; S.nN = 4; S.nwg = 256; S.G = G; S.c = c; S.i0 = 0; S.Loff = 0; S.pm_add = 0; S.pn_skip_from = 1 << 30; S.pn_skip_by = 0;
            pg8::Gemm g; g.A = WSP(p, bf16_t, WS_G); g.Bt = WSP(p, bf16_t, WS_WOUTT) + (size_t)layer * 1024 * 1024; g.K = 1024;
            EpiOut E;
            if (layer == 0) { E.xin = p.x_prompt; E.xo = WSP(p, float, WS_X1); }
            else { E.xin = WSP(p, float, WS_X1); E.xo = p.out + O_YP; }
            pg8::gemm_phase<EpiOut>(lds, g, S, E);
            sample_outproj(p, layer);
        }
#ifdef DUP_KIND
        }
#endif
    }
}

#ifndef SINGLE_LAUNCH
#define SINGLE_LAUNCH 1
#endif
extern "C" void kernel_launch(void* const* d_in, const int* in_sizes, int n_in, void* d_out, int out_size, void* d_ws, size_t ws_size, hipStream_t stream) {
    static int grid = 0;
    if (grid == 0) {
        int dev = 0, cus = 0, per_cu = 0;
        hipGetDevice(&dev);
        hipDeviceGetAttribute(&cus, hipDeviceAttributeMultiprocessorCount, dev);
        if (hipFuncSetAttribute((const void*)hymba_fwd, hipFuncAttributeMaxDynamicSharedMemorySize, LDS_BYTES) != hipSuccess) { fprintf(stderr, "hipFuncSetAttribute failed\n"); grid = -1; return; }
        if (hipOccupancyMaxActiveBlocksPerMultiprocessor(&per_cu, (const void*)hymba_fwd, NTHREADS, LDS_BYTES) != hipSuccess || per_cu < 1) { fprintf(stderr, "occupancy query: %d\n", per_cu); per_cu = 1; }
        (void)hipGetLastError();
        if (per_cu > 1) per_cu = 1;
        grid = cus * per_cu;
    }
    if (grid < 0) return;
    Params p{};
    p.x_prompt = (const float*)d_in[0]; p.x_sample = (const float*)d_in[1]; p.cache_k = (const float*)d_in[2]; p.cache_v = (const float*)d_in[3];
    p.norm_g = (const float*)d_in[4]; p.w_in = (const float*)d_in[5]; p.sgu_g = (const float*)d_in[6]; p.w_sp = (const float*)d_in[7]; p.b_sp = (const float*)d_in[8];
    p.qg = (const float*)d_in[9]; p.kg = (const float*)d_in[10]; p.w_out = (const float*)d_in[11];
    p.out = (float*)d_out;
    p.ws = (unsigned char*)d_ws;
    if (ws_size < WS_END) { fprintf(stderr, "workspace too small\n"); return; }
#if SINGLE_LAUNCH
    p.phase_lo = 0; p.phase_hi = 8;
    void* args[] = {&p};
    hipError_t e = hipLaunchCooperativeKernel((const void*)hymba_fwd, dim3(grid), dim3(NTHREADS), args, LDS_BYTES, stream);
    if (e != hipSuccess) fprintf(stderr, "cooperative launch failed: %s (grid %d)\n", hipGetErrorString(e), grid);
#else
    for (int ph = 0; ph < 8; ++ph) { p.phase_lo = ph; p.phase_hi = ph + 1; hipLaunchKernelGGL(hymba_fwd, dim3(grid), dim3(NTHREADS), LDS_BYTES, stream, p); }
#endif
}
```

```cpp
#include <hip/hip_runtime.h>
#include <hip/hip_cooperative_groups.h>
#include <cstdio>
namespace cg = cooperative_groups;

#define LAS __attribute__((address_space(3)))
typedef unsigned short bf16_t;
typedef short bf16x8 __attribute__((ext_vector_type(8)));
typedef float f32x4 __attribute__((ext_vector_type(4)));
typedef float f32x16 __attribute__((ext_vector_type(16)));
typedef unsigned u32x2 __attribute__((ext_vector_type(2)));
typedef unsigned u32x4 __attribute__((ext_vector_type(4)));

constexpr int D_MODEL = 1024, SEQ = 16384, NS = 32, TTOK = SEQ + NS  , MPAD = 16640, PROJ = 3840, CACHE = 2048;
constexpr int NTHREADS = 512;
constexpr int LDS_BYTES = 150 * 1024;
constexpr int LDS_XB = 128 * 1024;
constexpr int LDS_CTL = 150 * 1024 - 16;
constexpr float LOG2E = 1.4426950408889634f;

constexpr size_t O_YP = 0, O_YS = 16777216, O_KP = O_YS + 32768, O_VP = O_KP + 3145728, O_KS = O_VP + 3145728, O_VS = O_KS + 49152, O_SG = O_VS + 49152;

struct Params {
    const float *x_prompt, *x_sample, *cache_k, *cache_v, *norm_g, *w_in, *sgu_g, *w_sp, *b_sp, *qg, *kg, *w_out;
    float* out;
    unsigned char* ws;
    unsigned long long sched;
    int nsteps, extra_syncs;
};
constexpr size_t al4k(size_t b) { return (b + 4095) & ~(size_t)4095; }
constexpr size_t WS_WINT = 0;
constexpr size_t WS_WOUTT = WS_WINT + al4k((size_t)2 * PROJ * 1024 * 2);
constexpr size_t WS_HB = WS_WOUTT + al4k((size_t)2 * 1024 * 1024 * 2);
constexpr size_t WS_P = WS_HB + al4k((size_t)MPAD * 1024 * 2);
constexpr size_t WS_VT1 = WS_P + al4k((size_t)MPAD * PROJ * 2);
constexpr size_t WS_VT2 = WS_VT1 + al4k((size_t)768 * SEQ * 2);
constexpr size_t WS_VT3 = WS_VT2 + al4k((size_t)768 * SEQ * 2);
constexpr size_t WS_G = WS_VT3 + al4k((size_t)768 * SEQ * 2);
constexpr size_t WS_X1 = WS_G + al4k((size_t)MPAD * 1024 * 2);
constexpr size_t WS_KF = WS_X1 + al4k((size_t)TTOK * 1024 * 4);
constexpr size_t WS_CTL = WS_KF + 3 * al4k((size_t)768 * SEQ * 2);
constexpr size_t WS_BAR = WS_CTL + 4096;
constexpr size_t WS_END = WS_BAR + 16384;
#define WSP(p, T, OFF) ((T*)((p).ws + (OFF)))

__device__ __forceinline__ bf16_t f2bf(float f) { unsigned u = __float_as_uint(f); u += 0x7FFFu + ((u >> 16) & 1u); return (bf16_t)(u >> 16); }
__device__ __forceinline__ unsigned pk2(float lo, float hi) { return (unsigned)f2bf(lo) | ((unsigned)f2bf(hi) << 16); }
__device__ __forceinline__ float bf2f(bf16_t b) { return __uint_as_float(((unsigned)b) << 16); }
__device__ __forceinline__ float bflo(unsigned u) { return __uint_as_float(u << 16); }
__device__ __forceinline__ float bfhi(unsigned u) { return __uint_as_float(u & 0xFFFF0000u); }
__device__ __forceinline__ int opaque_tid() { int t = threadIdx.x; asm volatile("" : "+v"(t)); return t; }
__device__ __forceinline__ float silu(float x) { return x / (1.0f + __expf(-x)); }

#define XB_TMO      128
#define XB_XCNT(j)  (256  + 64 * (j))
#define XB_XSUB(j)  (1280 + 64 * (j))
#define XB_XGEN(j)  (2304 + 64 * (j))
#define XB_TOP      3328
#define XB_TOPGEN   3392
#define XCD_BAR_WORDS 3456
#define XB_SPIN_CAP (1u << 18)

__device__ __forceinline__ unsigned xb_ld(unsigned* p)              { return __hip_atomic_load(p, __ATOMIC_RELAXED, __HIP_MEMORY_SCOPE_AGENT); }
__device__ __forceinline__ unsigned xb_add(unsigned* p, unsigned v) { return __hip_atomic_fetch_add(p, v, __ATOMIC_RELAXED, __HIP_MEMORY_SCOPE_AGENT); }
__device__ __forceinline__ unsigned xb_xcc_id() { return (unsigned)__builtin_amdgcn_s_getreg((3 << 11) | 20) & 0xFu; }
#define XB_SPIN(cond, bar) do { unsigned _sp = 0; while (cond) { __builtin_amdgcn_s_sleep(1); \
    if ((++_sp & 255u) == 0u) { if (xb_ld(&(bar)[XB_TMO])) break; if (_sp > XB_SPIN_CAP) { atomicAdd(&(bar)[XB_TMO], 1u); break; } } } } while (0)

struct XcdBarrier {
    unsigned* bar; unsigned x;
    volatile LAS unsigned* st;
};

__device__ __forceinline__ XcdBarrier xcd_barrier_post(unsigned* bar, volatile LAS unsigned* st) {
    XcdBarrier b; b.bar = bar; b.x = xb_xcc_id(); b.st = st;
    if (threadIdx.x == 0) (void)xb_add(&bar[XB_XCNT(b.x)], 1u);
    return b;
}
__device__ __forceinline__ void xcd_barrier_complete(unsigned* bar, unsigned x, unsigned& nloc, unsigned& nx) {
    const unsigned G = gridDim.x * gridDim.y * gridDim.z;
    unsigned sum, cnt, mine, sp = 0u;
    for (;;) {
        sum = 0u; cnt = 0u; mine = 0u;
#pragma unroll
        for (unsigned j = 0; j < 16; ++j) { const unsigned c = xb_ld(&bar[XB_XCNT(j)]); sum += c; cnt += (c > 0u) ? 1u : 0u; mine = (j == x) ? c : mine; }
        if (sum == G) break;
        __builtin_amdgcn_s_sleep(1);
        if ((++sp & 255u) == 0u) { if (xb_ld(&bar[XB_TMO])) break; if (sp > XB_SPIN_CAP) { atomicAdd(&bar[XB_TMO], 1u); break; } }
    }
    nloc = mine > 0u ? mine : 1u; nx = cnt > 0u ? cnt : 1u;
}

__device__ __forceinline__ void xcd_barrier(const XcdBarrier& b) {
    asm volatile("s_waitcnt vmcnt(0)" ::: "memory");
    __syncthreads();
    if (threadIdx.x == 0) {
        unsigned* bar = b.bar;
        __builtin_amdgcn_s_waitcnt(0);
        unsigned nloc = b.st[0], nx = b.st[1];
        if (nloc == 0u) { xcd_barrier_complete(bar, b.x, nloc, nx); b.st[0] = nloc; b.st[1] = nx; }
        const unsigned old = xb_add(&bar[XB_XSUB(b.x)], 1u);
        const unsigned gen = old / nloc;
        if (old + 1u == (gen + 1u) * nloc) {
            __builtin_amdgcn_fence(__ATOMIC_RELEASE, "agent");
            asm volatile("s_waitcnt vmcnt(0)" ::: "memory");
            const unsigned og = xb_add(&bar[XB_TOP], 1u);
            const unsigned tg = og / nx;
            if (og + 1u == (tg + 1u) * nx) xb_add(&bar[XB_TOPGEN], 1u);
            else XB_SPIN(xb_ld(&bar[XB_TOPGEN]) == tg, bar);
            __builtin_amdgcn_fence(__ATOMIC_ACQUIRE, "agent");
            xb_add(&bar[XB_XGEN(b.x)], 1u);
            asm volatile("s_waitcnt vmcnt(0)" ::: "memory");
        } else {
            XB_SPIN(xb_ld(&bar[XB_XGEN(b.x)]) == gen, bar);
            __builtin_amdgcn_fence(__ATOMIC_ACQUIRE, "agent");
            asm volatile("s_waitcnt vmcnt(0)" ::: "memory");
        }
    }
    __syncthreads();
}


namespace pg8 {
constexpr int BM = 256, BK = 64, HALF = 128, HTB = HALF * BK * 2, STAGE_BYTES = 8 * HTB, NXCD = 8, WGM = 8;
__device__ __forceinline__ int lds_byte(int r, int c) { const int st = (r >> 4) * 2 + (c >> 5), rr = r & 15, cc = c & 31, ob = rr * 64 + cc * 2; return st * 1024 + (ob ^ (((ob >> 9) & 1) << 5)); }
__device__ __forceinline__ void stage_rc(int b, int& R, int& C) { const int st = b / 1024, sb = b % 1024, swz = sb ^ (((sb >> 9) & 1) << 5); R = (st >> 1) * 16 + swz / 64; C = (st & 1) * 32 + (swz % 64) / 2; }
struct Unit { int pm, pn; };
struct Gemm { const bf16_t* A; const bf16_t* Bt; int K; };

struct Order {
    int nM, nN, nwg, G, c, i0, Loff, pm_add, pn_skip_from, pn_skip_by;
    __device__ bool next(int i, Unit& u) const {
        const long L = (long)(i + i0) * G + c - Loff; if (L < 0 || L >= nwg) return false;
        int wgid = (int)L; { const int q = nwg / NXCD, r = nwg % NXCD, xcd = wgid % NXCD, off = wgid / NXCD; wgid = (xcd < r ? xcd * (q + 1) : r * (q + 1) + (xcd - r) * q) + off; }
        const int nig = WGM * nN, gid = wgid / nig, fm = gid * WGM, gsz = (nM - fm) < WGM ? (nM - fm) : WGM;
        u.pm = fm + ((wgid % nig) % gsz) + pm_add; int pn = (wgid % nig) / gsz; if (pn >= pn_skip_from) pn += pn_skip_by; u.pn = pn; return true;
    }
};

template <class Epi>
__device__ __forceinline__ void gemm_phase(LAS unsigned char* lds, const Gemm g, const Order& S, const Epi& E) {
    const int tid = opaque_tid(), wid = __builtin_amdgcn_readfirstlane(tid >> 6), lane = tid & 63, wr = wid >> 2, wc = wid & 3, fr = lane & 15, fq = lane >> 4;
    const int K = g.K, nt = K / BK;
    unsigned voffA[2], voffB[2];
#pragma unroll
    for (int i = 0; i < 2; ++i) { int R, C; stage_rc(tid * 16 + i * 8192, R, C); const int Rb = Epi::BPERM ? (64 * (R >> 5) + 16 * ((R >> 2) & 3) + 4 * ((R >> 4) & 1) + (R & 3)) : R;
        voffA[i] = (unsigned)(R * K + C) * 2u; voffB[i] = (unsigned)(Rb * K + C) * 2u; }
    const size_t kstep = (size_t)(BK * 2);
    const size_t hstep = (size_t)HALF * K * 2;
    const size_t hstepB = Epi::BPERM ? (size_t)8 * K * 2 : hstep;
    const size_t tstep = 2 * hstep;
    const unsigned ldsw = (unsigned)wid * 1024u;
    const int aoff = lds_byte(wr * 64 + fr, fq * 8), boff = lds_byte(wc * 32 + fr, fq * 8);
#define PG8_SA(b, h) (((b) * 2 + (h)) * HTB)
#define PG8_SB(b, h) ((4 + (b) * 2 + (h)) * HTB)
#define PG8_STAGE(bufoff, gbase, voff) do { _Pragma("unroll") for (int _i = 0; _i < 2; ++_i) \
        __builtin_amdgcn_global_load_lds((const unsigned*)((const char*)(gbase) + (voff)[_i]), (LAS unsigned*)(lds + (bufoff) + ldsw + _i * 8192), 16, 0, 0); } while (0)
#define PG8_LDA(dst, b, h) do { _Pragma("unroll") for (int m = 0; m < 4; ++m) _Pragma("unroll") for (int k = 0; k < 2; ++k) dst[m][k] = *(const LAS bf16x8*)(lds + PG8_SA(b, h) + aoff + m * 2048 + k * 1024); } while (0)
#define PG8_LDB(dst, b, h) do { _Pragma("unroll") for (int n = 0; n < 2; ++n) _Pragma("unroll") for (int k = 0; k < 2; ++k) dst[n][k] = *(const LAS bf16x8*)(lds + PG8_SB(b, h) + boff + n * 2048 + k * 1024); } while (0)
#define PG8_MMA(ai, bj, At, Bt) do { __builtin_amdgcn_s_setprio(1); _Pragma("unroll") for (int m = 0; m < 4; ++m) _Pragma("unroll") for (int n = 0; n < 2; ++n) _Pragma("unroll") for (int k = 0; k < 2; ++k) \
        acc[ai][bj][m][n] = __builtin_amdgcn_mfma_f32_16x16x32_bf16(Bt[n][k], At[m][k], acc[ai][bj][m][n], 0, 0, 0); __builtin_amdgcn_s_setprio(0); } while (0)
#define PG8_WAIT_V(n) asm volatile("s_waitcnt vmcnt(" #n ")" ::: "memory")
#define PG8_WAIT_L(n) asm volatile("s_waitcnt lgkmcnt(" #n ")" ::: "memory")
#define PG8_BAR __builtin_amdgcn_s_barrier()
#define PG8_SCHED __builtin_amdgcn_sched_barrier(0)
    Unit cur, nxt; int ui = 0;
    if (!S.next(0, cur)) return;
    f32x4 acc[2][2][4][2];
#pragma unroll
    for (int a = 0; a < 2; ++a)
#pragma unroll
        for (int b = 0; b < 2; ++b)
#pragma unroll
            for (int m = 0; m < 4; ++m)
#pragma unroll
                for (int n = 0; n < 2; ++n) acc[a][b][m][n] = (f32x4){0.f, 0.f, 0.f, 0.f};
    bf16x8 At[4][2], B0[2][2], B1[2][2];
    const char* cA = (const char*)g.A + (size_t)cur.pm * tstep; const char* cB = (const char*)g.Bt + (size_t)cur.pn * tstep;
    PG8_STAGE(PG8_SB(0, 0), cB, voffB); PG8_STAGE(PG8_SA(0, 0), cA, voffA); PG8_STAGE(PG8_SB(0, 1), cB + hstepB, voffB); PG8_STAGE(PG8_SA(0, 1), cA + hstep, voffA);
    if (wr == 1) PG8_BAR;
    PG8_WAIT_V(4); PG8_BAR;
    PG8_STAGE(PG8_SB(1, 0), cB + kstep, voffB); PG8_STAGE(PG8_SA(1, 0), cA + kstep, voffA); PG8_STAGE(PG8_SB(1, 1), cB + hstepB + kstep, voffB);
    PG8_WAIT_V(6); PG8_BAR;
    for (;;) {
        const bool has_next = S.next(ui + 1, nxt);
        const char* nA = has_next ? (const char*)g.A + (size_t)nxt.pm * tstep : cA; const char* nB = has_next ? (const char*)g.Bt + (size_t)nxt.pn * tstep : cB;
        for (int t = 0; t < nt; t += 2) {
            const bool last = (t == nt - 2);
            const char* a1 = cA + (size_t)(t + 1) * kstep;
            const char* a2 = last ? nA : cA + (size_t)(t + 2) * kstep; const char* b2 = last ? nB : cB + (size_t)(t + 2) * kstep;
            const char* a3 = a2 + kstep; const char* b3 = b2 + kstep;
            PG8_LDB(B0, 0, 0); PG8_SCHED; PG8_LDA(At, 0, 0); PG8_STAGE(PG8_SA(1, 1), a1 + hstep, voffA);
            PG8_WAIT_L(8); PG8_BAR; PG8_WAIT_L(0); PG8_MMA(0, 0, At, B0); PG8_BAR; PG8_SCHED;
            PG8_LDB(B1, 0, 1); PG8_STAGE(PG8_SB(0, 0), b2, voffB);
            PG8_BAR; PG8_WAIT_L(0); PG8_MMA(0, 1, At, B1); PG8_BAR;
            PG8_LDA(At, 0, 1); PG8_STAGE(PG8_SA(0, 0), a2, voffA);
            PG8_BAR; PG8_WAIT_L(0); PG8_MMA(1, 0, At, B0); PG8_BAR; PG8_SCHED;
            PG8_STAGE(PG8_SB(0, 1), b2 + hstepB, voffB);
            PG8_WAIT_V(6); PG8_BAR; PG8_MMA(1, 1, At, B1); PG8_BAR;
            PG8_LDB(B0, 1, 0); PG8_SCHED; PG8_LDA(At, 1, 0); PG8_STAGE(PG8_SA(0, 1), a2 + hstep, voffA);
            PG8_WAIT_L(8); PG8_BAR; PG8_WAIT_L(0); PG8_MMA(0, 0, At, B0); PG8_BAR; PG8_SCHED;
            PG8_LDB(B1, 1, 1); PG8_STAGE(PG8_SB(1, 0), b3, voffB);
            PG8_BAR; PG8_WAIT_L(0); PG8_MMA(0, 1, At, B1); PG8_BAR;
            PG8_LDA(At, 1, 1); PG8_STAGE(PG8_SA(1, 0), a3, voffA);
            PG8_BAR; PG8_WAIT_L(0); PG8_MMA(1, 0, At, B0); PG8_BAR; PG8_SCHED;
            PG8_STAGE(PG8_SB(1, 1), b3 + hstepB, voffB);
            PG8_WAIT_V(6); PG8_BAR; PG8_MMA(1, 1, At, B1); PG8_BAR;
        }
        E(acc, cur, wr, wc, fr, fq);
        if (!has_next) break;
#pragma unroll
        for (int a = 0; a < 2; ++a)
#pragma unroll
            for (int b = 0; b < 2; ++b)
#pragma unroll
                for (int m = 0; m < 4; ++m)
#pragma unroll
                    for (int n = 0; n < 2; ++n) acc[a][b][m][n] = (f32x4){0.f, 0.f, 0.f, 0.f};
        cur = nxt; cA = nA; cB = nB; ++ui;
    }
    PG8_WAIT_V(0);
    if (wr == 0) PG8_BAR;
    PG8_BAR;
#undef PG8_SA
#undef PG8_SB
#undef PG8_STAGE
#undef PG8_LDA
#undef PG8_LDB
#undef PG8_MMA
#undef PG8_WAIT_V
#undef PG8_WAIT_L
#undef PG8_BAR
#undef PG8_SCHED
}
}
using pg8::Unit;

__device__ __forceinline__ unsigned cvt_pk_bf16(float lo, float hi) { unsigned r; asm("v_cvt_pk_bf16_f32 %0, %1, %2" : "=v"(r) : "v"(lo), "v"(hi)); return r; }

struct EpiIn {
    static constexpr bool BPERM = true;
    bf16_t* P; bf16_t* KF; const float* qg; const float* kg; float* outk_p; float* outk_s;
    __device__ __forceinline__ void operator()(const f32x4 (&acc)[2][2][4][2], const Unit& u, int wr, int wc, int fr, int fq) const {
        const int pn = u.pn;
        const int kind = (pn >= 3 && pn < 6) ? 1 : ((pn >= 6 && pn < 9) ? 2 : 0);
        const int col0 = pn * 256 + wc * 64 + 16 * fq;
        f32x4 gv[2][2];
        const float* gp = kind == 1 ? qg : kg;
#pragma unroll
        for (int bj = 0; bj < 2; ++bj)
#pragma unroll
            for (int n = 0; n < 2; ++n) {
                if (kind) { gv[bj][n] = *(const f32x4*)(gp + 16 * fq + 8 * bj + 4 * n); if (kind == 1) gv[bj][n] = gv[bj][n] * (0.125f * LOG2E); }
                else gv[bj][n] = (f32x4){1.f, 1.f, 1.f, 1.f};
            }
#pragma unroll
        for (int ai = 0; ai < 2; ++ai)
#pragma unroll
            for (int m = 0; m < 4; ++m) {
                const int r = u.pm * 256 + ai * 128 + wr * 64 + m * 16 + fr;
                float rstd = 1.0f;
                if (kind) {
                    float ss = 0.f;
#pragma unroll
                    for (int bj = 0; bj < 2; ++bj)
#pragma unroll
                        for (int n = 0; n < 2; ++n)
#pragma unroll
                            for (int e = 0; e < 4; ++e) ss += acc[ai][bj][m][n][e] * acc[ai][bj][m][n][e];
                    ss += __shfl_xor(ss, 16); ss += __shfl_xor(ss, 32);
                    rstd = rsqrtf(ss * (1.0f / 64.0f) + 1e-6f);
                }
                f32x4 v[2][2];
#pragma unroll
                for (int bj = 0; bj < 2; ++bj)
#pragma unroll
                    for (int n = 0; n < 2; ++n) v[bj][n] = acc[ai][bj][m][n] * gv[bj][n] * rstd;
                if (r < TTOK) {
                    u32x4 o0, o1;
                    o0[0] = cvt_pk_bf16(v[0][0][0], v[0][0][1]); o0[1] = cvt_pk_bf16(v[0][0][2], v[0][0][3]); o0[2] = cvt_pk_bf16(v[0][1][0], v[0][1][1]); o0[3] = cvt_pk_bf16(v[0][1][2], v[0][1][3]);
                    o1[0] = cvt_pk_bf16(v[1][0][0], v[1][0][1]); o1[1] = cvt_pk_bf16(v[1][0][2], v[1][0][3]); o1[2] = cvt_pk_bf16(v[1][1][0], v[1][1][1]); o1[3] = cvt_pk_bf16(v[1][1][2], v[1][1][3]);
                    if (kind != 2) { bf16_t* dst = P + (size_t)r * PROJ + col0; *(u32x4*)dst = o0; *(u32x4*)(dst + 8) = o1; }
                    else if (r < SEQ) {
                        const int hk = (pn - 6) * 4 + wc;
#pragma unroll
                        for (int pat = 0; pat < 3; ++pat) {
                            const int ldil = 2 * pat, sidx = r >> ldil, res = r & ((1 << ldil) - 1);
                            bf16_t* dst = KF + (size_t)pat * ((size_t)768 * SEQ) + (size_t)(hk * 512 + res * (512 >> ldil) + (sidx >> 5)) * 2048 + fq * 512 + (sidx & 31) * 8;
                            *(u32x4*)dst = o0; *(u32x4*)(dst + 256) = o1;
                        }
                    }
                    if (kind == 2 && r >= SEQ - CACHE) {
                        float* od = r < SEQ ? outk_p + (size_t)(r - (SEQ - CACHE)) * 768 + (col0 - 1536) : outk_s + (size_t)(r - SEQ) * 768 + (col0 - 1536);
                        *(f32x4*)(od) = v[0][0]; *(f32x4*)(od + 4) = v[0][1]; *(f32x4*)(od + 8) = v[1][0]; *(f32x4*)(od + 12) = v[1][1];
                    }
                }
            }
    }
};
struct EpiV {
    static constexpr bool BPERM = true;
    bf16_t *VT1, *VT2, *VT3; float* outv_p; float* outv_s; LAS unsigned char* xb;
    __device__ __forceinline__ void operator()(const f32x4 (&acc)[2][2][4][2], const Unit& u, int wr, int wc, int fr, int fq) const {
        LAS unsigned char* xw = xb + (wr * 4 + wc) * 2304;
        const int tw = u.pn * 256 + wc * 64;
        const int t0 = tw + 16 * fq;
        const int lane = fr + 16 * fq;
#pragma unroll
        for (int ai = 0; ai < 2; ++ai)
#pragma unroll
            for (int m = 0; m < 4; ++m) {
                const int fbase = u.pm * 256 + ai * 128 + wr * 64 + m * 16 - 2304;
                const int fv = fbase + fr;
                if (tw < SEQ) {
                    u32x4 o0, o1;
                    o0[0] = cvt_pk_bf16(acc[ai][0][m][0][0], acc[ai][0][m][0][1]); o0[1] = cvt_pk_bf16(acc[ai][0][m][0][2], acc[ai][0][m][0][3]);
                    o0[2] = cvt_pk_bf16(acc[ai][0][m][1][0], acc[ai][0][m][1][1]); o0[3] = cvt_pk_bf16(acc[ai][0][m][1][2], acc[ai][0][m][1][3]);
                    o1[0] = cvt_pk_bf16(acc[ai][1][m][0][0], acc[ai][1][m][0][1]); o1[1] = cvt_pk_bf16(acc[ai][1][m][0][2], acc[ai][1][m][0][3]);
                    o1[2] = cvt_pk_bf16(acc[ai][1][m][1][0], acc[ai][1][m][1][1]); o1[3] = cvt_pk_bf16(acc[ai][1][m][1][2], acc[ai][1][m][1][3]);
                    const int hv = fv >> 6, dv = fv & 63, fo = (dv >> 5) * 1024 + (dv & 31) * 8;
                    {
                        u32x4 p0, p1; p0[0] = o0[0]; p0[1] = o0[1]; p0[2] = o1[0]; p0[3] = o1[1]; p1[0] = o0[2]; p1[1] = o0[3]; p1[2] = o1[2]; p1[3] = o1[3];
                        bf16_t* d1 = VT1 + (size_t)(hv * 512 + (t0 >> 5)) * 2048 + ((t0 >> 4) & 1) * 512 + fo;
                        *(u32x4*)d1 = p0; *(u32x4*)(d1 + 256) = p1;
                    }
#pragma unroll
                    for (int e = 0; e < 4; ++e) {
                        u32x2 w2; w2[0] = cvt_pk_bf16(acc[ai][0][m][0][e], acc[ai][0][m][1][e]); w2[1] = cvt_pk_bf16(acc[ai][1][m][0][e], acc[ai][1][m][1][e]);
                        const int si = t0 >> 2, qq = (si >> 2) & 3;
                        *(u32x2*)(VT2 + (size_t)(hv * 512 + e * 128 + (si >> 5)) * 2048 + ((si >> 4) & 1) * 512 + fo + (qq & 1) * 256 + (qq >> 1) * 4) = w2;
                    }
                    *(LAS u32x4*)(xw + fr * 144 + fq * 32) = o0; *(LAS u32x4*)(xw + fr * 144 + fq * 32 + 16) = o1;
#pragma unroll
                    for (int k = 0; k < 4; ++k) {
                        const int id = lane + 64 * k, f2 = id & 15, rho = id >> 4;
                        const LAS unsigned short* srcp = (const LAS unsigned short*)(xw + f2 * 144 + rho * 2);
                        const unsigned a0 = srcp[0], a1 = srcp[16], a2 = srcp[32], a3 = srcp[48];
                        u32x2 w3; w3[0] = a0 | (a1 << 16); w3[1] = a2 | (a3 << 16);
                        const int fv2 = fbase + f2, h2 = fv2 >> 6, d2 = fv2 & 63, si = tw >> 4, qq = (si >> 2) & 3;
                        *(u32x2*)(VT3 + (size_t)(h2 * 512 + rho * 32 + (si >> 5)) * 2048 + ((si >> 4) & 1) * 512 + (d2 >> 5) * 1024 + (d2 & 31) * 8 + (qq & 1) * 256 + (qq >> 1) * 4) = w3;
                    }
                    if (tw >= SEQ - CACHE) {
#pragma unroll
                        for (int bj = 0; bj < 2; ++bj)
#pragma unroll
                            for (int n = 0; n < 2; ++n)
#pragma unroll
                                for (int e = 0; e < 4; ++e) outv_p[(size_t)(t0 + 8 * bj + 4 * n + e - (SEQ - CACHE)) * 768 + fv] = acc[ai][bj][m][n][e];
                    }
                } else if (t0 < TTOK) {
#pragma unroll
                    for (int bj = 0; bj < 2; ++bj)
#pragma unroll
                        for (int n = 0; n < 2; ++n)
#pragma unroll
                            for (int e = 0; e < 4; ++e) outv_s[(size_t)(t0 + 8 * bj + 4 * n + e - SEQ) * 768 + fv] = acc[ai][bj][m][n][e];
                }
            }
    }
};
struct EpiOut {
    static constexpr bool BPERM = true;
    const float* xin; float* xo;
    __device__ __forceinline__ void operator()(const f32x4 (&acc)[2][2][4][2], const Unit& u, int wr, int wc, int fr, int fq) const {
        const int c0 = u.pn * 256 + wc * 64 + 16 * fq;
#pragma unroll
        for (int ai = 0; ai < 2; ++ai)
#pragma unroll
            for (int m = 0; m < 4; ++m) {
                const int r = u.pm * 256 + ai * 128 + wr * 64 + m * 16 + fr;
                const float* xi = xin + (size_t)r * 1024 + c0; float* xop = xo + (size_t)r * 1024 + c0;
                f32x4 x[2][2];
#pragma unroll
                for (int bj = 0; bj < 2; ++bj)
#pragma unroll
                    for (int n = 0; n < 2; ++n) x[bj][n] = *(const f32x4*)(xi + 8 * bj + 4 * n);
#pragma unroll
                for (int bj = 0; bj < 2; ++bj)
#pragma unroll
                    for (int n = 0; n < 2; ++n) *(f32x4*)(xop + 8 * bj + 4 * n) = x[bj][n] + acc[ai][bj][m][n];
            }
    }
};
__device__ void sample_outproj(const Params& p, int layer) {
    const int tid = opaque_tid(), dotid = tid >> 2, sub = tid & 3, row = dotid >> 2;
    const float* xi = layer == 0 ? p.x_sample : WSP(p, float, WS_X1) + (size_t)SEQ * 1024;
    float* xo = layer == 0 ? WSP(p, float, WS_X1) + (size_t)SEQ * 1024 : p.out + O_YS;
    for (int cb = blockIdx.x; cb < 256; cb += gridDim.x) {
        const int col = 4 * cb + (dotid & 3);
        const bf16_t* gp = WSP(p, bf16_t, WS_G) + (size_t)(SEQ + row) * 1024 + sub * 256;
        const bf16_t* wp = WSP(p, bf16_t, WS_WOUTT) + (size_t)layer * 1024 * 1024 + (size_t)col * 1024 + sub * 256;
        float a = 0.f;
#pragma unroll 8
        for (int i = 0; i < 32; ++i) {
            const u32x4 gv = *(const u32x4*)(gp + 8 * i), wv = *(const u32x4*)(wp + 8 * i);
#pragma unroll
            for (int j = 0; j < 4; ++j) a += bflo(gv[j]) * bflo(wv[j]) + bfhi(gv[j]) * bfhi(wv[j]);
        }
        a += __shfl_xor(a, 1); a += __shfl_xor(a, 2);
        if (sub == 0) xo[(size_t)row * 1024 + col] = xi[(size_t)row * 1024 + col] + a;
    }
}
__device__ __forceinline__ void tp_src(const Params& p, int t, const float*& src, bf16_t*& dst, int& N, int& kb, int& nb) {
    const int l = t / 1216; int tt = t - l * 1216;
    if (tt < 960) { src = p.w_in + (size_t)l * 1024 * PROJ; dst = WSP(p, bf16_t, WS_WINT) + (size_t)l * PROJ * 1024; N = PROJ; }
    else { tt -= 960; src = p.w_out + (size_t)l * 1024 * 1024; dst = WSP(p, bf16_t, WS_WOUTT) + (size_t)l * 1024 * 1024; N = 1024; }
    const int tilesN = N / 64; kb = (tt / tilesN) * 64; nb = (tt % tilesN) * 64;
}
__device__ void transpose_all(const Params& p, float* tile) {
    const int tid = opaque_tid(), G = gridDim.x;
    const int n = tid & 63, k0 = tid >> 6;
    float v[8];
    int t = blockIdx.x;
    if (t < 2432) { const float* src; bf16_t* dst; int N, kb, nb; tp_src(p, t, src, dst, N, kb, nb);
#pragma unroll
        for (int i = 0; i < 8; ++i) v[i] = src[(size_t)(kb + k0 + 8 * i) * N + nb + n]; }
    for (; t < 2432; t += G) {
        const float* src; bf16_t* dst; int N, kb, nb; tp_src(p, t, src, dst, N, kb, nb);
#pragma unroll
        for (int i = 0; i < 8; ++i) tile[(k0 + 8 * i) * 65 + n] = v[i];
        if (t + G < 2432) { const float* src2; bf16_t* dst2; int N2, kb2, nb2; tp_src(p, t + G, src2, dst2, N2, kb2, nb2);
#pragma unroll
            for (int i = 0; i < 8; ++i) v[i] = src2[(size_t)(kb2 + k0 + 8 * i) * N2 + nb2 + n]; }
        __syncthreads();
        {
            const int kp = (tid & 31) * 2, n0 = tid >> 5;
#pragma unroll
            for (int i = 0; i < 4; ++i) { const int nn = n0 + 16 * i; *(unsigned*)(dst + (size_t)(nb + nn) * 1024 + kb + kp) = cvt_pk_bf16(tile[kp * 65 + nn], tile[(kp + 1) * 65 + nn]); }
        }
        __syncthreads();
    }
}

__device__ void rmsnorm_rows(const Params& p, int layer) {
    const int tid = opaque_tid(), lane = tid & 63, wg = blockIdx.x * 8 + (tid >> 6), nw = gridDim.x * 8;
    const float* g = p.norm_g + layer * 1024;
    f32x4 gv[4];
#pragma unroll
    for (int i = 0; i < 4; ++i) gv[i] = *(const f32x4*)(g + i * 256 + lane * 4);
    for (int row0 = wg; row0 < TTOK; row0 += 4 * nw) {
        f32x4 v[4][4];
#pragma unroll
        for (int k = 0; k < 4; ++k) {
            int row = row0 + k * nw; row = row < TTOK ? row : row0;
            const float* src = layer == 0 ? (row < SEQ ? p.x_prompt + (size_t)row * 1024 : p.x_sample + (size_t)(row - SEQ) * 1024) : WSP(p, float, WS_X1) + (size_t)row * 1024;
#pragma unroll
            for (int i = 0; i < 4; ++i) v[k][i] = *(const f32x4*)(src + i * 256 + lane * 4);
        }
#pragma unroll
        for (int k = 0; k < 4; ++k) {
            const int row = row0 + k * nw;
            float ss = 0.f;
#pragma unroll
            for (int i = 0; i < 4; ++i) ss += v[k][i][0] * v[k][i][0] + v[k][i][1] * v[k][i][1] + v[k][i][2] * v[k][i][2] + v[k][i][3] * v[k][i][3];
#pragma unroll
            for (int o = 32; o >= 1; o >>= 1) ss += __shfl_xor(ss, o);
            const float rstd = rsqrtf(ss * (1.0f / 1024.0f) + 1e-6f);
            if (row < TTOK) {
#pragma unroll
                for (int i = 0; i < 4; ++i) { const f32x4 y = v[k][i] * rstd * gv[i];
                    u32x2 o; o[0] = cvt_pk_bf16(y[0], y[1]); o[1] = cvt_pk_bf16(y[2], y[3]); *(u32x2*)(WSP(p, bf16_t, WS_HB) + (size_t)row * 1024 + i * 256 + lane * 4) = o; }
            }
        }
    }
}

struct KVf { bf16x8 k[4]; bf16x8 v[2][2]; };
struct TileGeom { int pat, tt, kt, qb, ldil; };
__device__ __forceinline__ TileGeom tile_geom(int it, int w) {
    TileGeom g; g.pat = it >= 20 ? 2 : (it >= 10 ? 1 : 0); const int rem = it - 10 * g.pat; g.tt = rem >= 5 ? 1 : 0; g.kt = rem - 5 * g.tt;
    const int tl = w + 8 * g.tt; g.qb = g.pat == 0 ? 32 * tl : (g.pat == 1 ? 128 * (tl >> 2) + (tl & 3) : tl); g.ldil = 2 * g.pat; return g;
}
__device__ __forceinline__ void load_kv(KVf& f, const bf16_t* __restrict__ kfh  , const bf16_t* __restrict__ vfh  , int it, int w, int T0) {
    const TileGeom g = tile_geom(it, w);
    const int dil = 1 << g.ldil, qbase = T0 + g.qb, vidx0 = qbase >> g.ldil, res = qbase & (dil - 1), kk0 = -128 + 32 * g.kt;
    int tile = (vidx0 + kk0) >> 5; tile = tile < 0 ? 0 : tile;
    const size_t off = (size_t)g.pat * ((size_t)768 * SEQ) + (size_t)(res * (512 >> g.ldil) + tile) * 2048;
    const bf16_t* kp = kfh + off; const bf16_t* vp = vfh + off;
#pragma unroll
    for (int s = 0; s < 4; ++s) f.k[s] = *(const bf16x8*)(kp + 512 * s);
#pragma unroll
    for (int mt = 0; mt < 2; ++mt)
#pragma unroll
        for (int s2 = 0; s2 < 2; ++s2) f.v[mt][s2] = *(const bf16x8*)(vp + (mt * 2 + s2) * 512);
}
template <bool MASK>
__device__ __forceinline__ void attn_tile(const KVf& f, const bf16x8 (&qf)[4], f32x16& O0, f32x16& O1, float& den, float dsl, float base, int kk0, int vidx0, int c, int hh) {
    f32x16 S;
#pragma unroll
    for (int r = 0; r < 16; ++r) S[r] = fmaf(dsl, (float)((r & 3) + 8 * (r >> 2)), base);
#pragma unroll
    for (int s = 0; s < 4; ++s) S = __builtin_amdgcn_mfma_f32_32x32x16_bf16(f.k[s], qf[s], S, 0, 0, 0);
#pragma unroll
    for (int r = 0; r < 16; ++r) {
        float pv = __builtin_amdgcn_exp2f(S[r]);
        if (MASK) { const int kk = kk0 + (r & 3) + 8 * (r >> 2) + 4 * hh; const int dd = c - kk; const bool valid = (dd >= 0) && (dd <= 128) && (vidx0 + kk >= 0); pv = valid ? pv : 0.f; }
        den += pv; S[r] = pv;
    }
#pragma unroll
    for (int s2 = 0; s2 < 2; ++s2) {
        u32x4 pw;
#pragma unroll
        for (int j = 0; j < 4; ++j) pw[j] = cvt_pk_bf16(S[8 * s2 + 2 * j], S[8 * s2 + 2 * j + 1]);
        const bf16x8 pf = __builtin_bit_cast(bf16x8, pw);
        O0 = __builtin_amdgcn_mfma_f32_32x32x16_bf16(f.v[0][s2], pf, O0, 0, 0, 0);
        O1 = __builtin_amdgcn_mfma_f32_32x32x16_bf16(f.v[1][s2], pf, O1, 0, 0, 0);
    }
}

__device__ void attn_item(const Params& p, int layer, int sb, int h, float* accL, float Mref2) {
    const int tid = opaque_tid(), w = tid >> 6, lane = tid & 63, c = lane & 31, hh = lane >> 5;
    const int T0 = sb * 512;
    const float sl2 = exp2f(-8.0f * (float)(h + 1) / 12.0f) * LOG2E;
    const bf16_t* __restrict__ P = WSP(p, bf16_t, WS_P);
    const bf16_t* __restrict__ qbasep = P + 768 + h * 64 + 8 * hh;
    const bf16_t* __restrict__ kfh = WSP(p, bf16_t, WS_KF) + (size_t)h * (512 * 2048) + lane * 8;
    const bf16_t* __restrict__ vfh = WSP(p, bf16_t, WS_VT1) + (size_t)h * (512 * 2048) + lane * 8;
    KVf f0, f1, f2;
    bf16x8 qf[4];
    f32x16 O0, O1; float den = 0.f;
#pragma unroll
    for (int r = 0; r < 16; ++r) { O0[r] = 0.f; O1[r] = 0.f; }
    { const TileGeom g = tile_geom(0, w); const bf16_t* qp = qbasep + (size_t)(T0 + g.qb + (c << g.ldil)) * PROJ;
#pragma unroll
      for (int s = 0; s < 4; ++s) qf[s] = *(const bf16x8*)(qp + 16 * s); }
    load_kv(f0, kfh, vfh, 0, w, T0);
    load_kv(f1, kfh, vfh, 1, w, T0);
#define ATTN_STEP(FA, FC, IT) { \
        const int it_ = (IT); \
        if (it_ + 2 < 30) load_kv(FC, kfh, vfh, it_ + 2, w, T0); \
        const TileGeom g = tile_geom(it_, w); \
        const int dil = 1 << g.ldil, qbase = T0 + g.qb, vidx0 = qbase >> g.ldil, kk0 = -128 + 32 * g.kt; \
        if (g.kt == 0) { _Pragma("unroll") for (int r = 0; r < 16; ++r) { O0[r] = 0.f; O1[r] = 0.f; } den = 0.f; } \
        const float dsl = sl2 * (float)dil; \
        const float base = dsl * (float)(kk0 - c + 4 * hh) - Mref2; \
        if (g.kt == 0 || g.kt == 4 || vidx0 < 128) attn_tile<true>(FA, qf, O0, O1, den, dsl, base, kk0, vidx0, c, hh); \
        else attn_tile<false>(FA, qf, O0, O1, den, dsl, base, kk0, vidx0, c, hh); \
        if (g.kt == 4) { \
            if (it_ + 1 < 30) { const TileGeom gn = tile_geom(it_ + 1, w); const bf16_t* qp = qbasep + (size_t)(T0 + gn.qb + (c << gn.ldil)) * PROJ; \
                _Pragma("unroll") for (int s = 0; s < 4; ++s) qf[s] = *(const bf16x8*)(qp + 16 * s); } \
            const float dt = den + __shfl_xor(den, 32); \
            float* arow = accL + (g.qb + (c << g.ldil)) * 65; \
            if (g.pat == 0) { \
                _Pragma("unroll") for (int r = 0; r < 16; ++r) { const int d = (r & 3) + 8 * (r >> 2) + 4 * hh; arow[d] = O0[r]; arow[32 + d] = O1[r]; } \
                if (hh == 0) arow[64] = dt; \
            } else { \
                _Pragma("unroll") for (int r = 0; r < 16; ++r) { const int d = (r & 3) + 8 * (r >> 2) + 4 * hh; arow[d] += O0[r]; arow[32 + d] += O1[r]; } \
                if (hh == 0) arow[64] += dt; \
            } \
            if (g.tt == 1) __syncthreads(); \
        } }
#pragma unroll 1
    for (int it = 0; it < 30; it += 3) {
        ATTN_STEP(f0, f2, it);
        ATTN_STEP(f1, f0, it + 1);
        ATTN_STEP(f2, f1, it + 2);
    }
#undef ATTN_STEP
    bf16_t* __restrict__ Gp = WSP(p, bf16_t, WS_G);
#pragma unroll 1
    for (int it = 0; it < 4; ++it) {
        unsigned zb[8];
#pragma unroll
        for (int j = 0; j < 8; ++j) { const int idx = tid + NTHREADS * (it * 8 + j); const int ql = idx >> 5, d2 = (idx & 31) * 2;
            zb[j] = *(const unsigned*)(P + (size_t)(T0 + ql) * PROJ + 3072 + h * 64 + d2); }
#pragma unroll
        for (int j = 0; j < 8; ++j) { const int idx = tid + NTHREADS * (it * 8 + j); const int ql = idx >> 5, d2 = (idx & 31) * 2;
            const float inv = 1.0f / accL[ql * 65 + 64];
            const float o0 = accL[ql * 65 + d2] * inv * silu(bflo(zb[j])), o1 = accL[ql * 65 + d2 + 1] * inv * silu(bfhi(zb[j]));
            *(unsigned*)(Gp + (size_t)(T0 + ql) * 1024 + 256 + h * 64 + d2) = cvt_pk_bf16(o0, o1); }
    }
    __syncthreads();
}

__device__ void sgu_item(const Params& p, int layer, int ch, int g, bf16_t* vnT  ) {
    const int tid = opaque_tid(), w = tid >> 6, lane = tid & 63, c = lane & 31, hh = lane >> 5;
    const int R0 = ch * 128;
    const bf16_t* __restrict__ P = WSP(p, bf16_t, WS_P);
    const float* sg = p.sgu_g + layer * 256;
    const int tt = w >> 1, dt = w & 1;
    const int t = 32 * tt + c;
    const float* wrow = p.w_sp + ((size_t)(layer * 4 + g) * 128 + t) * 128 + 8 * hh;
    u32x2 vv[16];
#pragma unroll
    for (int rr = 0; rr < 16; ++rr) vv[rr] = *(const u32x2*)(P + (size_t)(R0 + w * 16 + rr) * PROJ + 256 + lane * 4);
    f32x4 w0[8], w1[8];
#pragma unroll
    for (int ks = 0; ks < 8; ++ks) { if (ks <= 2 * tt + 1) { w0[ks] = *(const f32x4*)(wrow + 16 * ks); w1[ks] = *(const f32x4*)(wrow + 16 * ks + 4); } else { w0[ks] = (f32x4){0.f, 0.f, 0.f, 0.f}; w1[ks] = w0[ks]; } }
    const f32x4 gv = *(const f32x4*)(sg + g * 64 + (lane & 15) * 4);
#pragma unroll
    for (int rr = 0; rr < 16; ++rr) {
        const int row = w * 16 + rr;
        const float f0 = bflo(vv[rr][0]), f1 = bfhi(vv[rr][0]), f2 = bflo(vv[rr][1]), f3 = bfhi(vv[rr][1]);
        float ss = f0 * f0 + f1 * f1 + f2 * f2 + f3 * f3;
#pragma unroll
        for (int o = 32; o >= 1; o >>= 1) ss += __shfl_xor(ss, o);
        const float rstd = rsqrtf(ss * (1.0f / 256.0f) + 1e-6f);
        if ((lane >> 4) == g) {
            const int dl = (lane & 15) * 4;
            vnT[(dl + 0) * 136 + row] = f2bf(f0 * rstd * gv[0]); vnT[(dl + 1) * 136 + row] = f2bf(f1 * rstd * gv[1]);
            vnT[(dl + 2) * 136 + row] = f2bf(f2 * rstd * gv[2]); vnT[(dl + 3) * 136 + row] = f2bf(f3 * rstd * gv[3]);
        }
    }
    const float* bsp = p.b_sp + (size_t)(layer * 4 + g) * 128;
    const int colA = g * 64 + 32 * dt + c;
    bf16_t uav[16], zav[16]; float bv[16];
#pragma unroll
    for (int r = 0; r < 16; ++r) { const int tr = 32 * tt + (r & 3) + 8 * (r >> 2) + 4 * hh; const size_t row = (size_t)(R0 + tr);
        uav[r] = P[row * PROJ + colA]; zav[r] = P[row * PROJ + 512 + colA]; bv[r] = bsp[tr]; }
    __syncthreads();
    f32x16 acc;
#pragma unroll
    for (int r = 0; r < 16; ++r) acc[r] = 0.f;
#pragma unroll
    for (int ks = 0; ks < 8; ++ks) {
        if (ks <= 2 * tt + 1) {
            const int s0 = 16 * ks + 8 * hh;
            u32x4 aw;
            aw[0] = cvt_pk_bf16(s0 + 0 <= t ? w0[ks][0] : 0.f, s0 + 1 <= t ? w0[ks][1] : 0.f); aw[1] = cvt_pk_bf16(s0 + 2 <= t ? w0[ks][2] : 0.f, s0 + 3 <= t ? w0[ks][3] : 0.f);
            aw[2] = cvt_pk_bf16(s0 + 4 <= t ? w1[ks][0] : 0.f, s0 + 5 <= t ? w1[ks][1] : 0.f); aw[3] = cvt_pk_bf16(s0 + 6 <= t ? w1[ks][2] : 0.f, s0 + 7 <= t ? w1[ks][3] : 0.f);
            const bf16x8 bfrag = *(const bf16x8*)(vnT + (32 * dt + c) * 136 + s0);
            acc = __builtin_amdgcn_mfma_f32_32x32x16_bf16(__builtin_bit_cast(bf16x8, aw), bfrag, acc, 0, 0, 0);
        }
    }
    bf16_t* __restrict__ Gp = WSP(p, bf16_t, WS_G);
#pragma unroll
    for (int r = 0; r < 16; ++r) {
        const int tr = 32 * tt + (r & 3) + 8 * (r >> 2) + 4 * hh;
        Gp[(size_t)(R0 + tr) * 1024 + colA] = f2bf(bf2f(uav[r]) * (acc[r] + bv[r]) * silu(bf2f(zav[r])));
    }
    __syncthreads();
}

__device__ void sattn_item(const Params& p, int layer, int b, int h, float* part  , float Mref) {
    const int tid = opaque_tid();
    const float slope = exp2f(-8.0f * (float)(h + 1) / 12.0f);
    const size_t tok = (size_t)(SEQ + b);
    const bf16_t* __restrict__ P = WSP(p, bf16_t, WS_P);
    const float* ck = p.cache_k + ((size_t)(layer * NS + b) * CACHE) * 768 + h * 64;
    const float* cv = p.cache_v + ((size_t)(layer * NS + b) * CACHE) * 768 + h * 64;
    const float* nk = p.out + O_KS + ((size_t)(layer * NS + b)) * 768 + h * 64;
    const float* nv = p.out + O_VS + ((size_t)(layer * NS + b)) * 768 + h * 64;
    const int sub = tid & 15, grp = tid >> 4;
    f32x4 k4[13], v4[13];
#pragma unroll
    for (int it = 0; it < 13; ++it) {
        const int e = it * 32 + grp; const int ee = e < 387 ? e : 0; const int pat = ee >= 258 ? 2 : (ee >= 129 ? 1 : 0); const int j = ee - pat * 129; const int dist = j << (2 * pat);
        const float* kr = dist == 0 ? nk : ck + (size_t)(CACHE - dist) * 768;
        const float* vr = dist == 0 ? nv : cv + (size_t)(CACHE - dist) * 768;
        k4[it] = *(const f32x4*)(kr + sub * 4); v4[it] = *(const f32x4*)(vr + sub * 4);
    }
    f32x4 q4;
    { const u32x2 qv = *(const u32x2*)(P + tok * PROJ + 768 + h * 64 + sub * 4); q4[0] = bflo(qv[0]); q4[1] = bfhi(qv[0]); q4[2] = bflo(qv[1]); q4[3] = bfhi(qv[1]); }
    const float zbv = tid < 64 ? bf2f(P[tok * PROJ + 3072 + h * 64 + tid]) : 0.f;
    f32x4 acc = (f32x4){0.f, 0.f, 0.f, 0.f}; float den = 0.f;
#pragma unroll
    for (int it = 0; it < 13; ++it) {
        const int e = it * 32 + grp; const bool act = e < 387; const int ee = act ? e : 0; const int pat = ee >= 258 ? 2 : (ee >= 129 ? 1 : 0); const int j = ee - pat * 129; const int dist = j << (2 * pat);
        float d = q4[0] * k4[it][0] + q4[1] * k4[it][1] + q4[2] * k4[it][2] + q4[3] * k4[it][3];
        d += __shfl_xor(d, 1); d += __shfl_xor(d, 2); d += __shfl_xor(d, 4); d += __shfl_xor(d, 8);
        const float pe = act ? __builtin_amdgcn_exp2f(d - slope * LOG2E * (float)dist - Mref * LOG2E) : 0.f;
        acc += v4[it] * pe; den += pe;
    }
    *(f32x4*)(part + grp * 68 + sub * 4) = acc; if (sub == 0) part[grp * 68 + 64] = den;
    __syncthreads();
    if (tid < 64) {
        float num = 0.f, dn = 0.f;
#pragma unroll
        for (int k = 0; k < 32; ++k) { num += part[k * 68 + tid]; dn += part[k * 68 + 64]; }
        WSP(p, bf16_t, WS_G)[tok * 1024 + 256 + h * 64 + tid] = f2bf(num / dn * silu(zbv));
    }
    __syncthreads();
}

__device__ void ssgu_item(const Params& p, int layer) {
    const int tid = opaque_tid(), w = tid >> 6, lane = tid & 63;
    const float* sg = p.sgu_g + layer * 256;
    const bf16_t* __restrict__ P = WSP(p, bf16_t, WS_P);
    for (int rr = 0; rr < 4; ++rr) {
        const int b = w * 4 + rr; const size_t tok = (size_t)(SEQ + b);
        const u32x2 v = *(const u32x2*)(P + tok * PROJ + 256 + lane * 4);
        const u32x2 uav = *(const u32x2*)(P + tok * PROJ + lane * 4), zav = *(const u32x2*)(P + tok * PROJ + 512 + lane * 4);
        float f[4] = {bflo(v[0]), bfhi(v[0]), bflo(v[1]), bfhi(v[1])};
        float ss = f[0] * f[0] + f[1] * f[1] + f[2] * f[2] + f[3] * f[3];
#pragma unroll
        for (int o = 32; o >= 1; o >>= 1) ss += __shfl_xor(ss, o);
        const float rstd = rsqrtf(ss * (1.0f / 256.0f) + 1e-6f);
        const int g = lane >> 4;
        const float w00 = p.w_sp[(size_t)(layer * 4 + g) * 128 * 128], b0 = p.b_sp[(size_t)(layer * 4 + g) * 128];
        const float ua[4] = {bflo(uav[0]), bfhi(uav[0]), bflo(uav[1]), bfhi(uav[1])}, za[4] = {bflo(zav[0]), bfhi(zav[0]), bflo(zav[1]), bfhi(zav[1])};
        const f32x4 gv = *(const f32x4*)(sg + lane * 4);
        f32x4 vn; float o[4];
#pragma unroll
        for (int e = 0; e < 4; ++e) { vn[e] = f[e] * rstd * gv[e]; o[e] = ua[e] * (w00 * vn[e] + b0) * silu(za[e]); }
        *(f32x4*)(p.out + O_SG + ((size_t)(layer * NS + b)) * 256 + lane * 4) = vn;
        u32x2 go; go[0] = pk2(o[0], o[1]); go[1] = pk2(o[2], o[3]);
        *(u32x2*)(WSP(p, bf16_t, WS_G) + tok * 1024 + lane * 4) = go;
    }
    __syncthreads();
}

__global__ void __launch_bounds__(NTHREADS, 2) hymba_fwd(Params p) {
    extern __shared__ __attribute__((aligned(16))) unsigned char shm[];
    cg::grid_group grid = cg::this_grid();
    const int G = gridDim.x, c = blockIdx.x;
    volatile LAS unsigned* xst = (volatile LAS unsigned*)((LAS unsigned char*)shm + LDS_CTL + 8);
    if (threadIdx.x == 0) { xst[0] = 0u; xst[1] = 0u; }
    __syncthreads();
    (void)xcd_barrier_post(WSP(p, unsigned, WS_BAR), xst);
    for (int step = 0; step < p.nsteps; ++step) {
        if (step > 0) { XcdBarrier xb; xb.bar = WSP(p, unsigned, WS_BAR); xb.x = xb_xcc_id(); xb.st = (volatile LAS unsigned*)((LAS unsigned char*)shm + LDS_CTL + 8); xcd_barrier(xb); }
        const int ph = (int)((p.sched >> (4 * step)) & 15ull);
        const int layer = ph >> 2, kind = ph & 3;
        if (kind == 0) {
            if (layer == 0) {
                { const int t0_ = opaque_tid(); if (c == 0 && t0_ < 256) WSP(p, int, WS_CTL)[t0_] = 0; }
                transpose_all(p, (float*)shm);
            }
            rmsnorm_rows(p, layer);
        } else if (kind == 1) {
            LAS unsigned char* lds = (LAS unsigned char*)shm;
            const bf16_t* W = WSP(p, bf16_t, WS_WINT) + (size_t)layer * PROJ * 1024;
            {
                pg8::Order S; S.nM = 65; S.nN = 12; S.nwg = 780; S.G = G; S.c = c; S.i0 = 0; S.Loff = 0; S.pm_add = 0; S.pn_skip_from = 9; S.pn_skip_by = 3;
                pg8::Gemm g; g.A = WSP(p, bf16_t, WS_HB); g.Bt = W; g.K = 1024;
                EpiIn E; E.P = WSP(p, bf16_t, WS_P); E.KF = WSP(p, bf16_t, WS_KF); E.qg = p.qg + layer * 64; E.kg = p.kg + layer * 64; E.outk_p = p.out + O_KP + (size_t)layer * CACHE * 768; E.outk_s = p.out + O_KS + (size_t)layer * NS * 768;
                pg8::gemm_phase<EpiIn>(lds, g, S, E);
            }
            {
                pg8::Order S; S.nM = 3; S.nN = 65; S.nwg = 195; S.G = G; S.c = c; S.i0 = c < 780 ? (780 - c + G - 1) / G : 0; S.Loff = 780; S.pm_add = 9; S.pn_skip_from = 1 << 30; S.pn_skip_by = 0;
                pg8::Gemm g; g.A = W; g.Bt = WSP(p, bf16_t, WS_HB); g.K = 1024;
                EpiV E; E.VT1 = WSP(p, bf16_t, WS_VT1); E.VT2 = WSP(p, bf16_t, WS_VT2); E.VT3 = WSP(p, bf16_t, WS_VT3); E.outv_p = p.out + O_VP + (size_t)layer * CACHE * 768; E.outv_s = p.out + O_VS + (size_t)layer * NS * 768;
                E.xb = lds + LDS_XB;
                pg8::gemm_phase<EpiV>(lds, g, S, E);
            }
        } else if (kind == 2) {
            float gq = 0.f, gk = 0.f;
            for (int i = 0; i < 64; ++i) { gq = fmaxf(gq, fabsf(p.qg[layer * 64 + i])); gk = fmaxf(gk, fabsf(p.kg[layer * 64 + i])); }
            const float Mref = 8.2f * gq * gk;
            int* ctr = WSP(p, int, WS_CTL) + step * 16;
            volatile int* slot = (volatile int*)(shm + LDS_CTL);
            int qsteal = 0;
            auto fetch = [&]() -> int {
                while (qsteal < 8) { const int q = (c + qsteal) & 7; const int idx = atomicAdd(ctr + q, 1); if (idx < 48) return q * 48 + idx; ++qsteal; }
                return 384 + atomicAdd(ctr + 8, 1);
            };
            if (threadIdx.x == 0) *slot = fetch();
            __syncthreads();
            int item = *slot;
            while (item < 1281) {
                __syncthreads();
                int nxt = 0;
                if (threadIdx.x == 0) nxt = fetch();
                if (item < 384) attn_item(p, layer, item & 31, item >> 5, (float*)shm, Mref * LOG2E);
                else if (item < 768) sattn_item(p, layer, (item - 384) / 12, (item - 384) % 12, (float*)shm, Mref);
                else if (item < 1280) sgu_item(p, layer, (item - 768) >> 2, (item - 768) & 3, (bf16_t*)shm);
                else ssgu_item(p, layer);
                if (threadIdx.x == 0) *slot = nxt;
                __syncthreads();
                item = *slot;
            }
        } else {
            LAS unsigned char* lds = (LAS unsigned char*)shm;
            pg8::Order S; S.nM = 64; S.nN = 4; S.nwg = 256; S.G = G; S.c = c; S.i0 = 0; S.Loff = 0; S.pm_add = 0; S.pn_skip_from = 1 << 30; S.pn_skip_by = 0;
            pg8::Gemm g; g.A = WSP(p, bf16_t, WS_G); g.Bt = WSP(p, bf16_t, WS_WOUTT) + (size_t)layer * 1024 * 1024; g.K = 1024;
            EpiOut E;
            if (layer == 0) { E.xin = p.x_prompt; E.xo = WSP(p, float, WS_X1); }
            else { E.xin = WSP(p, float, WS_X1); E.xo = p.out + O_YP; }
            pg8::gemm_phase<EpiOut>(lds, g, S, E);
            sample_outproj(p, layer);
        }
    }
    for (int i = 0; i < p.extra_syncs; ++i) grid.sync();
}

#ifndef SINGLE_LAUNCH
#define SINGLE_LAUNCH 1
#endif
extern "C" void kernel_launch(void* const* d_in, const int* in_sizes, int n_in, void* d_out, int out_size, void* d_ws, size_t ws_size, hipStream_t stream) {
    static int grid = 0;
    if (grid == 0) {
        int dev = 0, cus = 0, per_cu = 0;
        hipGetDevice(&dev);
        hipDeviceGetAttribute(&cus, hipDeviceAttributeMultiprocessorCount, dev);
        if (hipFuncSetAttribute((const void*)hymba_fwd, hipFuncAttributeMaxDynamicSharedMemorySize, LDS_BYTES) != hipSuccess) { fprintf(stderr, "hipFuncSetAttribute failed\n"); grid = -1; return; }
        if (hipOccupancyMaxActiveBlocksPerMultiprocessor(&per_cu, (const void*)hymba_fwd, NTHREADS, LDS_BYTES) != hipSuccess || per_cu < 1) { fprintf(stderr, "occupancy query: %d\n", per_cu); per_cu = 1; }
        (void)hipGetLastError();
        if (per_cu > 1) per_cu = 1;
        grid = cus * per_cu;
    }
    if (grid < 0) return;
    Params p{};
    p.x_prompt = (const float*)d_in[0]; p.x_sample = (const float*)d_in[1]; p.cache_k = (const float*)d_in[2]; p.cache_v = (const float*)d_in[3];
    p.norm_g = (const float*)d_in[4]; p.w_in = (const float*)d_in[5]; p.sgu_g = (const float*)d_in[6]; p.w_sp = (const float*)d_in[7]; p.b_sp = (const float*)d_in[8];
    p.qg = (const float*)d_in[9]; p.kg = (const float*)d_in[10]; p.w_out = (const float*)d_in[11];
    p.out = (float*)d_out;
    p.ws = (unsigned char*)d_ws;
    if (ws_size < WS_END) { fprintf(stderr, "workspace too small\n"); return; }
#if SINGLE_LAUNCH
#ifndef PROBE_SCHED
#define PROBE_SCHED 0x76543210ull
#define PROBE_NSTEPS 8
#endif
#ifndef PROBE_SYNCS
#define PROBE_SYNCS 0
#endif
    p.sched = PROBE_SCHED; p.nsteps = PROBE_NSTEPS; p.extra_syncs = PROBE_SYNCS;
    (void)hipMemsetAsync((unsigned char*)d_ws + WS_BAR, 0, XCD_BAR_WORDS * sizeof(unsigned), stream);
    void* args[] = {&p};
    hipError_t e = hipLaunchCooperativeKernel((const void*)hymba_fwd, dim3(grid), dim3(NTHREADS), args, LDS_BYTES, stream);
    if (e != hipSuccess) fprintf(stderr, "cooperative launch failed: %s (grid %d)\n", hipGetErrorString(e), grid);
#else
    for (int ph = 0; ph < 8; ++ph) { p.sched = (unsigned long long)ph; p.nsteps = 1; p.extra_syncs = 0; hipLaunchKernelGGL(hymba_fwd, dim3(grid), dim3(NTHREADS), LDS_BYTES, stream, p); }
#endif
}
```

```cpp
#include <hip/hip_runtime.h>
#include <hip/hip_cooperative_groups.h>
#include <cstdio>
namespace cg = cooperative_groups;

#define LAS __attribute__((address_space(3)))
typedef unsigned short bf16_t;
typedef short bf16x8 __attribute__((ext_vector_type(8)));
typedef float f32x4 __attribute__((ext_vector_type(4)));
typedef float f32x16 __attribute__((ext_vector_type(16)));
typedef unsigned u32x2 __attribute__((ext_vector_type(2)));
typedef unsigned u32x4 __attribute__((ext_vector_type(4)));

constexpr int D_MODEL = 1024, SEQ = 16384, NS = 32, TTOK = SEQ + NS  , MPAD = 16640, PROJ = 3840, CACHE = 2048;
constexpr int NTHREADS = 512;
constexpr int LDS_BYTES = 150 * 1024;
constexpr int LDS_XB = 128 * 1024;
constexpr int LDS_CTL = 150 * 1024 - 16;
constexpr float LOG2E = 1.4426950408889634f;

constexpr size_t O_YP = 0, O_YS = 16777216, O_KP = O_YS + 32768, O_VP = O_KP + 3145728, O_KS = O_VP + 3145728, O_VS = O_KS + 49152, O_SG = O_VS + 49152;

struct Params {
    const float *x_prompt, *x_sample, *cache_k, *cache_v, *norm_g, *w_in, *sgu_g, *w_sp, *b_sp, *qg, *kg, *w_out;
    float* out;
    unsigned char* ws;
    unsigned long long sched;
    int nsteps, extra_syncs;
};
constexpr size_t al4k(size_t b) { return (b + 4095) & ~(size_t)4095; }
constexpr size_t WS_WINT = 0;
constexpr size_t WS_WOUTT = WS_WINT + al4k((size_t)2 * PROJ * 1024 * 2);
constexpr size_t WS_HB = WS_WOUTT + al4k((size_t)2 * 1024 * 1024 * 2);
constexpr size_t WS_P = WS_HB + al4k((size_t)MPAD * 1024 * 2);
constexpr size_t WS_VT1 = WS_P + al4k((size_t)MPAD * PROJ * 2);
constexpr size_t WS_VT2 = WS_VT1 + al4k((size_t)768 * SEQ * 2);
constexpr size_t WS_VT3 = WS_VT2 + al4k((size_t)768 * SEQ * 2);
constexpr size_t WS_G = WS_VT3 + al4k((size_t)768 * SEQ * 2);
constexpr size_t WS_X1 = WS_G + al4k((size_t)MPAD * 1024 * 2);
constexpr size_t WS_KF = WS_X1 + al4k((size_t)TTOK * 1024 * 4);
constexpr size_t WS_CTL = WS_KF + 3 * al4k((size_t)768 * SEQ * 2);
constexpr size_t WS_BAR = WS_CTL + 4096;
constexpr size_t WS_END = WS_BAR + 16384;
#define WSP(p, T, OFF) ((T*)((p).ws + (OFF)))

__device__ __forceinline__ bf16_t f2bf(float f) { unsigned u = __float_as_uint(f); u += 0x7FFFu + ((u >> 16) & 1u); return (bf16_t)(u >> 16); }
__device__ __forceinline__ unsigned pk2(float lo, float hi) { return (unsigned)f2bf(lo) | ((unsigned)f2bf(hi) << 16); }
__device__ __forceinline__ float bf2f(bf16_t b) { return __uint_as_float(((unsigned)b) << 16); }
__device__ __forceinline__ float bflo(unsigned u) { return __uint_as_float(u << 16); }
__device__ __forceinline__ float bfhi(unsigned u) { return __uint_as_float(u & 0xFFFF0000u); }
__device__ __forceinline__ int opaque_tid() { int t = threadIdx.x; asm volatile("" : "+v"(t)); return t; }
__device__ __forceinline__ float silu(float x) { return x / (1.0f + __expf(-x)); }

#define XB_TMO      128
#define XB_XCNT(j)  (256  + 64 * (j))
#define XB_XSUB(j)  (1280 + 64 * (j))
#define XB_XGEN(j)  (2304 + 64 * (j))
#define XB_TOP      3328
#define XB_TOPGEN   3392
#define XCD_BAR_WORDS 3456
#define XB_SPIN_CAP (1u << 18)

__device__ __forceinline__ unsigned xb_ld(unsigned* p)              { return __hip_atomic_load(p, __ATOMIC_RELAXED, __HIP_MEMORY_SCOPE_AGENT); }
__device__ __forceinline__ unsigned xb_add(unsigned* p, unsigned v) { return __hip_atomic_fetch_add(p, v, __ATOMIC_RELAXED, __HIP_MEMORY_SCOPE_AGENT); }
__device__ __forceinline__ unsigned xb_xcc_id() { return (unsigned)__builtin_amdgcn_s_getreg((3 << 11) | 20) & 0xFu; }
#define XB_SPIN(cond, bar) do { unsigned _sp = 0; while (cond) { __builtin_amdgcn_s_sleep(1); \
    if ((++_sp & 255u) == 0u) { if (xb_ld(&(bar)[XB_TMO])) break; if (_sp > XB_SPIN_CAP) { atomicAdd(&(bar)[XB_TMO], 1u); break; } } } } while (0)

struct XcdBarrier {
    unsigned* bar; unsigned x;
    volatile LAS unsigned* st;
};

__device__ __forceinline__ XcdBarrier xcd_barrier_post(unsigned* bar, volatile LAS unsigned* st) {
    XcdBarrier b; b.bar = bar; b.x = xb_xcc_id(); b.st = st;
    if (threadIdx.x == 0) (void)xb_add(&bar[XB_XCNT(b.x)], 1u);
    return b;
}
__device__ __forceinline__ void xcd_barrier_complete(unsigned* bar, unsigned x, unsigned& nloc, unsigned& nx) {
    const unsigned G = gridDim.x * gridDim.y * gridDim.z;
    unsigned sum, cnt, mine, sp = 0u;
    for (;;) {
        sum = 0u; cnt = 0u; mine = 0u;
#pragma unroll
        for (unsigned j = 0; j < 16; ++j) { const unsigned c = xb_ld(&bar[XB_XCNT(j)]); sum += c; cnt += (c > 0u) ? 1u : 0u; mine = (j == x) ? c : mine; }
        if (sum == G) break;
        __builtin_amdgcn_s_sleep(1);
        if ((++sp & 255u) == 0u) { if (xb_ld(&bar[XB_TMO])) break; if (sp > XB_SPIN_CAP) { atomicAdd(&bar[XB_TMO], 1u); break; } }
    }
    nloc = mine > 0u ? mine : 1u; nx = cnt > 0u ? cnt : 1u;
}

__device__ __forceinline__ void xcd_barrier(const XcdBarrier& b) {
    asm volatile("s_waitcnt vmcnt(0)" ::: "memory");
    __syncthreads();
    if (threadIdx.x == 0) {
        unsigned* bar = b.bar;
        __builtin_amdgcn_s_waitcnt(0);
        unsigned nloc = b.st[0], nx = b.st[1];
        if (nloc == 0u) { xcd_barrier_complete(bar, b.x, nloc, nx); b.st[0] = nloc; b.st[1] = nx; }
        const unsigned old = xb_add(&bar[XB_XSUB(b.x)], 1u);
        const unsigned gen = old / nloc;
        if (old + 1u == (gen + 1u) * nloc) {
            __builtin_amdgcn_fence(__ATOMIC_RELEASE, "agent");
            asm volatile("s_waitcnt vmcnt(0)" ::: "memory");
            const unsigned og = xb_add(&bar[XB_TOP], 1u);
            const unsigned tg = og / nx;
            if (og + 1u == (tg + 1u) * nx) xb_add(&bar[XB_TOPGEN], 1u);
            else XB_SPIN(xb_ld(&bar[XB_TOPGEN]) == tg, bar);
            __builtin_amdgcn_fence(__ATOMIC_ACQUIRE, "agent");
            xb_add(&bar[XB_XGEN(b.x)], 1u);
            asm volatile("s_waitcnt vmcnt(0)" ::: "memory");
        } else {
            XB_SPIN(xb_ld(&bar[XB_XGEN(b.x)]) == gen, bar);
            __builtin_amdgcn_fence(__ATOMIC_ACQUIRE, "agent");
            asm volatile("s_waitcnt vmcnt(0)" ::: "memory");
        }
    }
    __syncthreads();
}


namespace pg8 {
constexpr int BM = 256, BK = 64, HALF = 128, HTB = HALF * BK * 2, STAGE_BYTES = 8 * HTB, NXCD = 8, WGM = 8;
__device__ __forceinline__ int lds_byte(int r, int c) { const int st = (r >> 4) * 2 + (c >> 5), rr = r & 15, cc = c & 31, ob = rr * 64 + cc * 2; return st * 1024 + (ob ^ (((ob >> 9) & 1) << 5)); }
__device__ __forceinline__ void stage_rc(int b, int& R, int& C) { const int st = b / 1024, sb = b % 1024, swz = sb ^ (((sb >> 9) & 1) << 5); R = (st >> 1) * 16 + swz / 64; C = (st & 1) * 32 + (swz % 64) / 2; }
struct Unit { int pm, pn; };
struct Gemm { const bf16_t* A; const bf16_t* Bt; int K; };

struct Order {
    int nM, nN, nwg, G, c, i0, Loff, pm_add, pn_skip_from, pn_skip_by;
    __device__ bool next(int i, Unit& u) const {
        const long L = (long)(i + i0) * G + c - Loff; if (L < 0 || L >= nwg) return false;
        int wgid = (int)L; { const int q = nwg / NXCD, r = nwg % NXCD, xcd = wgid % NXCD, off = wgid / NXCD; wgid = (xcd < r ? xcd * (q + 1) : r * (q + 1) + (xcd - r) * q) + off; }
        const int nig = WGM * nN, gid = wgid / nig, fm = gid * WGM, gsz = (nM - fm) < WGM ? (nM - fm) : WGM;
        u.pm = fm + ((wgid % nig) % gsz) + pm_add; int pn = (wgid % nig) / gsz; if (pn >= pn_skip_from) pn += pn_skip_by; u.pn = pn; return true;
    }
};

template <class Epi>
__device__ __forceinline__ void gemm_phase(LAS unsigned char* lds, const Gemm g, const Order& S, const Epi& E) {
    const int tid = opaque_tid(), wid = __builtin_amdgcn_readfirstlane(tid >> 6), lane = tid & 63, wr = wid >> 2, wc = wid & 3, fr = lane & 15, fq = lane >> 4;
    const int K = g.K, nt = K / BK;
    unsigned voffA[2], voffB[2];
#pragma unroll
    for (int i = 0; i < 2; ++i) { int R, C; stage_rc(tid * 16 + i * 8192, R, C); const int Rb = Epi::BPERM ? (64 * (R >> 5) + 16 * ((R >> 2) & 3) + 4 * ((R >> 4) & 1) + (R & 3)) : R;
        voffA[i] = (unsigned)(R * K + C) * 2u; voffB[i] = (unsigned)(Rb * K + C) * 2u; }
    const size_t kstep = (size_t)(BK * 2);
    const size_t hstep = (size_t)HALF * K * 2;
    const size_t hstepB = Epi::BPERM ? (size_t)8 * K * 2 : hstep;
    const size_t tstep = 2 * hstep;
    const unsigned ldsw = (unsigned)wid * 1024u;
    const int aoff = lds_byte(wr * 64 + fr, fq * 8), boff = lds_byte(wc * 32 + fr, fq * 8);
#define PG8_SA(b, h) (((b) * 2 + (h)) * HTB)
#define PG8_SB(b, h) ((4 + (b) * 2 + (h)) * HTB)
#define PG8_STAGE(bufoff, gbase, voff) do { _Pragma("unroll") for (int _i = 0; _i < 2; ++_i) \
        __builtin_amdgcn_global_load_lds((const unsigned*)((const char*)(gbase) + (voff)[_i]), (LAS unsigned*)(lds + (bufoff) + ldsw + _i * 8192), 16, 0, 0); } while (0)
#define PG8_LDA(dst, b, h) do { _Pragma("unroll") for (int m = 0; m < 4; ++m) _Pragma("unroll") for (int k = 0; k < 2; ++k) dst[m][k] = *(const LAS bf16x8*)(lds + PG8_SA(b, h) + aoff + m * 2048 + k * 1024); } while (0)
#define PG8_LDB(dst, b, h) do { _Pragma("unroll") for (int n = 0; n < 2; ++n) _Pragma("unroll") for (int k = 0; k < 2; ++k) dst[n][k] = *(const LAS bf16x8*)(lds + PG8_SB(b, h) + boff + n * 2048 + k * 1024); } while (0)
#define PG8_MMA(ai, bj, At, Bt) do { __builtin_amdgcn_s_setprio(1); _Pragma("unroll") for (int m = 0; m < 4; ++m) _Pragma("unroll") for (int n = 0; n < 2; ++n) _Pragma("unroll") for (int k = 0; k < 2; ++k) \
        acc[ai][bj][m][n] = __builtin_amdgcn_mfma_f32_16x16x32_bf16(Bt[n][k], At[m][k], acc[ai][bj][m][n], 0, 0, 0); __builtin_amdgcn_s_setprio(0); } while (0)
#define PG8_WAIT_V(n) asm volatile("s_waitcnt vmcnt(" #n ")" ::: "memory")
#define PG8_WAIT_L(n) asm volatile("s_waitcnt lgkmcnt(" #n ")" ::: "memory")
#define PG8_BAR __builtin_amdgcn_s_barrier()
#define PG8_SCHED __builtin_amdgcn_sched_barrier(0)
    Unit cur, nxt; int ui = 0;
    if (!S.next(0, cur)) return;
    f32x4 acc[2][2][4][2];
#pragma unroll
    for (int a = 0; a < 2; ++a)
#pragma unroll
        for (int b = 0; b < 2; ++b)
#pragma unroll
            for (int m = 0; m < 4; ++m)
#pragma unroll
                for (int n = 0; n < 2; ++n) acc[a][b][m][n] = (f32x4){0.f, 0.f, 0.f, 0.f};
    bf16x8 At[4][2], B0[2][2], B1[2][2];
    const char* cA = (const char*)g.A + (size_t)cur.pm * tstep; const char* cB = (const char*)g.Bt + (size_t)cur.pn * tstep;
    PG8_STAGE(PG8_SB(0, 0), cB, voffB); PG8_STAGE(PG8_SA(0, 0), cA, voffA); PG8_STAGE(PG8_SB(0, 1), cB + hstepB, voffB); PG8_STAGE(PG8_SA(0, 1), cA + hstep, voffA);
    if (wr == 1) PG8_BAR;
    PG8_WAIT_V(4); PG8_BAR;
    PG8_STAGE(PG8_SB(1, 0), cB + kstep, voffB); PG8_STAGE(PG8_SA(1, 0), cA + kstep, voffA); PG8_STAGE(PG8_SB(1, 1), cB + hstepB + kstep, voffB);
    PG8_WAIT_V(6); PG8_BAR;
    for (;;) {
        const bool has_next = S.next(ui + 1, nxt);
        const char* nA = has_next ? (const char*)g.A + (size_t)nxt.pm * tstep : cA; const char* nB = has_next ? (const char*)g.Bt + (size_t)nxt.pn * tstep : cB;
        for (int t = 0; t < nt; t += 2) {
            const bool last = (t == nt - 2);
            const char* a1 = cA + (size_t)(t + 1) * kstep;
            const char* a2 = last ? nA : cA + (size_t)(t + 2) * kstep; const char* b2 = last ? nB : cB + (size_t)(t + 2) * kstep;
            const char* a3 = a2 + kstep; const char* b3 = b2 + kstep;
            PG8_LDB(B0, 0, 0); PG8_SCHED; PG8_LDA(At, 0, 0); PG8_STAGE(PG8_SA(1, 1), a1 + hstep, voffA);
            PG8_WAIT_L(8); PG8_BAR; PG8_WAIT_L(0); PG8_MMA(0, 0, At, B0); PG8_BAR; PG8_SCHED;
            PG8_LDB(B1, 0, 1); PG8_STAGE(PG8_SB(0, 0), b2, voffB);
            PG8_BAR; PG8_WAIT_L(0); PG8_MMA(0, 1, At, B1); PG8_BAR;
            PG8_LDA(At, 0, 1); PG8_STAGE(PG8_SA(0, 0), a2, voffA);
            PG8_BAR; PG8_WAIT_L(0); PG8_MMA(1, 0, At, B0); PG8_BAR; PG8_SCHED;
            PG8_STAGE(PG8_SB(0, 1), b2 + hstepB, voffB);
            PG8_WAIT_V(6); PG8_BAR; PG8_MMA(1, 1, At, B1); PG8_BAR;
            PG8_LDB(B0, 1, 0); PG8_SCHED; PG8_LDA(At, 1, 0); PG8_STAGE(PG8_SA(0, 1), a2 + hstep, voffA);
            PG8_WAIT_L(8); PG8_BAR; PG8_WAIT_L(0); PG8_MMA(0, 0, At, B0); PG8_BAR; PG8_SCHED;
            PG8_LDB(B1, 1, 1); PG8_STAGE(PG8_SB(1, 0), b3, voffB);
            PG8_BAR; PG8_WAIT_L(0); PG8_MMA(0, 1, At, B1); PG8_BAR;
            PG8_LDA(At, 1, 1); PG8_STAGE(PG8_SA(1, 0), a3, voffA);
            PG8_BAR; PG8_WAIT_L(0); PG8_MMA(1, 0, At, B0); PG8_BAR; PG8_SCHED;
            PG8_STAGE(PG8_SB(1, 1), b3 + hstepB, voffB);
            PG8_WAIT_V(6); PG8_BAR; PG8_MMA(1, 1, At, B1); PG8_BAR;
        }
        E(acc, cur, wr, wc, fr, fq);
        if (!has_next) break;
#pragma unroll
        for (int a = 0; a < 2; ++a)
#pragma unroll
            for (int b = 0; b < 2; ++b)
#pragma unroll
                for (int m = 0; m < 4; ++m)
#pragma unroll
                    for (int n = 0; n < 2; ++n) acc[a][b][m][n] = (f32x4){0.f, 0.f, 0.f, 0.f};
        cur = nxt; cA = nA; cB = nB; ++ui;
    }
    PG8_WAIT_V(0);
    if (wr == 0) PG8_BAR;
    PG8_BAR;
#undef PG8_SA
#undef PG8_SB
#undef PG8_STAGE
#undef PG8_LDA
#undef PG8_LDB
#undef PG8_MMA
#undef PG8_WAIT_V
#undef PG8_WAIT_L
#undef PG8_BAR
#undef PG8_SCHED
}
}
using pg8::Unit;

__device__ __forceinline__ unsigned cvt_pk_bf16(float lo, float hi) { unsigned r; asm("v_cvt_pk_bf16_f32 %0, %1, %2" : "=v"(r) : "v"(lo), "v"(hi)); return r; }

struct EpiIn {
    static constexpr bool BPERM = true;
    bf16_t* P; bf16_t* KF; const float* qg; const float* kg; float* outk_p; float* outk_s;
    __device__ __forceinline__ void operator()(const f32x4 (&acc)[2][2][4][2], const Unit& u, int wr, int wc, int fr, int fq) const {
        const int pn = u.pn;
        const int kind = (pn >= 3 && pn < 6) ? 1 : ((pn >= 6 && pn < 9) ? 2 : 0);
        const int col0 = pn * 256 + wc * 64 + 16 * fq;
        f32x4 gv[2][2];
        const float* gp = kind == 1 ? qg : kg;
#pragma unroll
        for (int bj = 0; bj < 2; ++bj)
#pragma unroll
            for (int n = 0; n < 2; ++n) {
                if (kind) { gv[bj][n] = *(const f32x4*)(gp + 16 * fq + 8 * bj + 4 * n); if (kind == 1) gv[bj][n] = gv[bj][n] * (0.125f * LOG2E); }
                else gv[bj][n] = (f32x4){1.f, 1.f, 1.f, 1.f};
            }
#pragma unroll
        for (int ai = 0; ai < 2; ++ai)
#pragma unroll
            for (int m = 0; m < 4; ++m) {
                const int r = u.pm * 256 + ai * 128 + wr * 64 + m * 16 + fr;
                float rstd = 1.0f;
                if (kind) {
                    float ss = 0.f;
#pragma unroll
                    for (int bj = 0; bj < 2; ++bj)
#pragma unroll
                        for (int n = 0; n < 2; ++n)
#pragma unroll
                            for (int e = 0; e < 4; ++e) ss += acc[ai][bj][m][n][e] * acc[ai][bj][m][n][e];
                    ss += __shfl_xor(ss, 16); ss += __shfl_xor(ss, 32);
                    rstd = rsqrtf(ss * (1.0f / 64.0f) + 1e-6f);
                }
                f32x4 v[2][2];
#pragma unroll
                for (int bj = 0; bj < 2; ++bj)
#pragma unroll
                    for (int n = 0; n < 2; ++n) v[bj][n] = acc[ai][bj][m][n] * gv[bj][n] * rstd;
                if (r < TTOK) {
                    u32x4 o0, o1;
                    o0[0] = cvt_pk_bf16(v[0][0][0], v[0][0][1]); o0[1] = cvt_pk_bf16(v[0][0][2], v[0][0][3]); o0[2] = cvt_pk_bf16(v[0][1][0], v[0][1][1]); o0[3] = cvt_pk_bf16(v[0][1][2], v[0][1][3]);
                    o1[0] = cvt_pk_bf16(v[1][0][0], v[1][0][1]); o1[1] = cvt_pk_bf16(v[1][0][2], v[1][0][3]); o1[2] = cvt_pk_bf16(v[1][1][0], v[1][1][1]); o1[3] = cvt_pk_bf16(v[1][1][2], v[1][1][3]);
                    if (kind != 2) { bf16_t* dst = P + (size_t)r * PROJ + col0; *(u32x4*)dst = o0; *(u32x4*)(dst + 8) = o1; }
                    else if (r < SEQ) {
                        const int hk = (pn - 6) * 4 + wc;
#pragma unroll
                        for (int pat = 0; pat < 3; ++pat) {
                            const int ldil = 2 * pat, sidx = r >> ldil, res = r & ((1 << ldil) - 1);
                            bf16_t* dst = KF + (size_t)pat * ((size_t)768 * SEQ) + (size_t)(hk * 512 + res * (512 >> ldil) + (sidx >> 5)) * 2048 + fq * 512 + (sidx & 31) * 8;
                            *(u32x4*)dst = o0; *(u32x4*)(dst + 256) = o1;
                        }
                    }
                    if (kind == 2 && r >= SEQ - CACHE) {
                        float* od = r < SEQ ? outk_p + (size_t)(r - (SEQ - CACHE)) * 768 + (col0 - 1536) : outk_s + (size_t)(r - SEQ) * 768 + (col0 - 1536);
                        *(f32x4*)(od) = v[0][0]; *(f32x4*)(od + 4) = v[0][1]; *(f32x4*)(od + 8) = v[1][0]; *(f32x4*)(od + 12) = v[1][1];
                    }
                }
            }
    }
};
struct EpiV {
    static constexpr bool BPERM = true;
    bf16_t *VT1, *VT2, *VT3; float* outv_p; float* outv_s; LAS unsigned char* xb;
    __device__ __forceinline__ void operator()(const f32x4 (&acc)[2][2][4][2], const Unit& u, int wr, int wc, int fr, int fq) const {
        LAS unsigned char* xw = xb + (wr * 4 + wc) * 2304;
        const int tw = u.pn * 256 + wc * 64;
        const int t0 = tw + 16 * fq;
        const int lane = fr + 16 * fq;
#pragma unroll
        for (int ai = 0; ai < 2; ++ai)
#pragma unroll
            for (int m = 0; m < 4; ++m) {
                const int fbase = u.pm * 256 + ai * 128 + wr * 64 + m * 16 - 2304;
                const int fv = fbase + fr;
                if (tw < SEQ) {
                    u32x4 o0, o1;
                    o0[0] = cvt_pk_bf16(acc[ai][0][m][0][0], acc[ai][0][m][0][1]); o0[1] = cvt_pk_bf16(acc[ai][0][m][0][2], acc[ai][0][m][0][3]);
                    o0[2] = cvt_pk_bf16(acc[ai][0][m][1][0], acc[ai][0][m][1][1]); o0[3] = cvt_pk_bf16(acc[ai][0][m][1][2], acc[ai][0][m][1][3]);
                    o1[0] = cvt_pk_bf16(acc[ai][1][m][0][0], acc[ai][1][m][0][1]); o1[1] = cvt_pk_bf16(acc[ai][1][m][0][2], acc[ai][1][m][0][3]);
                    o1[2] = cvt_pk_bf16(acc[ai][1][m][1][0], acc[ai][1][m][1][1]); o1[3] = cvt_pk_bf16(acc[ai][1][m][1][2], acc[ai][1][m][1][3]);
                    const int hv = fv >> 6, dv = fv & 63, fo = (dv >> 5) * 1024 + (dv & 31) * 8;
                    {
                        u32x4 p0, p1; p0[0] = o0[0]; p0[1] = o0[1]; p0[2] = o1[0]; p0[3] = o1[1]; p1[0] = o0[2]; p1[1] = o0[3]; p1[2] = o1[2]; p1[3] = o1[3];
                        bf16_t* d1 = VT1 + (size_t)(hv * 512 + (t0 >> 5)) * 2048 + ((t0 >> 4) & 1) * 512 + fo;
                        *(u32x4*)d1 = p0; *(u32x4*)(d1 + 256) = p1;
                    }
#pragma unroll
                    for (int e = 0; e < 4; ++e) {
                        u32x2 w2; w2[0] = cvt_pk_bf16(acc[ai][0][m][0][e], acc[ai][0][m][1][e]); w2[1] = cvt_pk_bf16(acc[ai][1][m][0][e], acc[ai][1][m][1][e]);
                        const int si = t0 >> 2, qq = (si >> 2) & 3;
                        *(u32x2*)(VT2 + (size_t)(hv * 512 + e * 128 + (si >> 5)) * 2048 + ((si >> 4) & 1) * 512 + fo + (qq & 1) * 256 + (qq >> 1) * 4) = w2;
                    }
                    *(LAS u32x4*)(xw + fr * 144 + fq * 32) = o0; *(LAS u32x4*)(xw + fr * 144 + fq * 32 + 16) = o1;
#pragma unroll
                    for (int k = 0; k < 4; ++k) {
                        const int id = lane + 64 * k, f2 = id & 15, rho = id >> 4;
                        const LAS unsigned short* srcp = (const LAS unsigned short*)(xw + f2 * 144 + rho * 2);
                        const unsigned a0 = srcp[0], a1 = srcp[16], a2 = srcp[32], a3 = srcp[48];
                        u32x2 w3; w3[0] = a0 | (a1 << 16); w3[1] = a2 | (a3 << 16);
                        const int fv2 = fbase + f2, h2 = fv2 >> 6, d2 = fv2 & 63, si = tw >> 4, qq = (si >> 2) & 3;
                        *(u32x2*)(VT3 + (size_t)(h2 * 512 + rho * 32 + (si >> 5)) * 2048 + ((si >> 4) & 1) * 512 + (d2 >> 5) * 1024 + (d2 & 31) * 8 + (qq & 1) * 256 + (qq >> 1) * 4) = w3;
                    }
                    if (tw >= SEQ - CACHE) {
#pragma unroll
                        for (int bj = 0; bj < 2; ++bj)
#pragma unroll
                            for (int n = 0; n < 2; ++n)
#pragma unroll
                                for (int e = 0; e < 4; ++e) outv_p[(size_t)(t0 + 8 * bj + 4 * n + e - (SEQ - CACHE)) * 768 + fv] = acc[ai][bj][m][n][e];
                    }
                } else if (t0 < TTOK) {
#pragma unroll
                    for (int bj = 0; bj < 2; ++bj)
#pragma unroll
                        for (int n = 0; n < 2; ++n)
#pragma unroll
                            for (int e = 0; e < 4; ++e) outv_s[(size_t)(t0 + 8 * bj + 4 * n + e - SEQ) * 768 + fv] = acc[ai][bj][m][n][e];
                }
            }
    }
};
struct EpiOut {
    static constexpr bool BPERM = true;
    const float* xin; float* xo;
    __device__ __forceinline__ void operator()(const f32x4 (&acc)[2][2][4][2], const Unit& u, int wr, int wc, int fr, int fq) const {
        const int c0 = u.pn * 256 + wc * 64 + 16 * fq;
#pragma unroll
        for (int ai = 0; ai < 2; ++ai)
#pragma unroll
            for (int m = 0; m < 4; ++m) {
                const int r = u.pm * 256 + ai * 128 + wr * 64 + m * 16 + fr;
                const float* xi = xin + (size_t)r * 1024 + c0; float* xop = xo + (size_t)r * 1024 + c0;
                f32x4 x[2][2];
#pragma unroll
                for (int bj = 0; bj < 2; ++bj)
#pragma unroll
                    for (int n = 0; n < 2; ++n) x[bj][n] = *(const f32x4*)(xi + 8 * bj + 4 * n);
#pragma unroll
                for (int bj = 0; bj < 2; ++bj)
#pragma unroll
                    for (int n = 0; n < 2; ++n) *(f32x4*)(xop + 8 * bj + 4 * n) = x[bj][n] + acc[ai][bj][m][n];
            }
    }
};
__device__ void sample_outproj(const Params& p, int layer) {
    const int tid = opaque_tid(), dotid = tid >> 2, sub = tid & 3, row = dotid >> 2;
    const float* xi = layer == 0 ? p.x_sample : WSP(p, float, WS_X1) + (size_t)SEQ * 1024;
    float* xo = layer == 0 ? WSP(p, float, WS_X1) + (size_t)SEQ * 1024 : p.out + O_YS;
    for (int cb = blockIdx.x; cb < 256; cb += gridDim.x) {
        const int col = 4 * cb + (dotid & 3);
        const bf16_t* gp = WSP(p, bf16_t, WS_G) + (size_t)(SEQ + row) * 1024 + sub * 256;
        const bf16_t* wp = WSP(p, bf16_t, WS_WOUTT) + (size_t)layer * 1024 * 1024 + (size_t)col * 1024 + sub * 256;
        float a = 0.f;
#pragma unroll 8
        for (int i = 0; i < 32; ++i) {
            const u32x4 gv = *(const u32x4*)(gp + 8 * i), wv = *(const u32x4*)(wp + 8 * i);
#pragma unroll
            for (int j = 0; j < 4; ++j) a += bflo(gv[j]) * bflo(wv[j]) + bfhi(gv[j]) * bfhi(wv[j]);
        }
        a += __shfl_xor(a, 1); a += __shfl_xor(a, 2);
        if (sub == 0) xo[(size_t)row * 1024 + col] = xi[(size_t)row * 1024 + col] + a;
    }
}
__device__ __forceinline__ void tp_src(const Params& p, int t, const float*& src, bf16_t*& dst, int& N, int& kb, int& nb) {
    const int l = t / 1216; int tt = t - l * 1216;
    if (tt < 960) { src = p.w_in + (size_t)l * 1024 * PROJ; dst = WSP(p, bf16_t, WS_WINT) + (size_t)l * PROJ * 1024; N = PROJ; }
    else { tt -= 960; src = p.w_out + (size_t)l * 1024 * 1024; dst = WSP(p, bf16_t, WS_WOUTT) + (size_t)l * 1024 * 1024; N = 1024; }
    const int tilesN = N / 64; kb = (tt / tilesN) * 64; nb = (tt % tilesN) * 64;
}
__device__ void transpose_all(const Params& p, float* tile) {
    const int tid = opaque_tid(), G = gridDim.x;
    const int n = tid & 63, k0 = tid >> 6;
    float v[8];
    int t = blockIdx.x;
    if (t < 2432) { const float* src; bf16_t* dst; int N, kb, nb; tp_src(p, t, src, dst, N, kb, nb);
#pragma unroll
        for (int i = 0; i < 8; ++i) v[i] = src[(size_t)(kb + k0 + 8 * i) * N + nb + n]; }
    for (; t < 2432; t += G) {
        const float* src; bf16_t* dst; int N, kb, nb; tp_src(p, t, src, dst, N, kb, nb);
#pragma unroll
        for (int i = 0; i < 8; ++i) tile[(k0 + 8 * i) * 65 + n] = v[i];
        if (t + G < 2432) { const float* src2; bf16_t* dst2; int N2, kb2, nb2; tp_src(p, t + G, src2, dst2, N2, kb2, nb2);
#pragma unroll
            for (int i = 0; i < 8; ++i) v[i] = src2[(size_t)(kb2 + k0 + 8 * i) * N2 + nb2 + n]; }
        __syncthreads();
        {
            const int kp = (tid & 31) * 2, n0 = tid >> 5;
#pragma unroll
            for (int i = 0; i < 4; ++i) { const int nn = n0 + 16 * i; *(unsigned*)(dst + (size_t)(nb + nn) * 1024 + kb + kp) = cvt_pk_bf16(tile[kp * 65 + nn], tile[(kp + 1) * 65 + nn]); }
        }
        __syncthreads();
    }
}

__device__ void rmsnorm_rows(const Params& p, int layer) {
    const int tid = opaque_tid(), lane = tid & 63, wg = blockIdx.x * 8 + (tid >> 6), nw = gridDim.x * 8;
    const float* g = p.norm_g + layer * 1024;
    f32x4 gv[4];
#pragma unroll
    for (int i = 0; i < 4; ++i) gv[i] = *(const f32x4*)(g + i * 256 + lane * 4);
    for (int row0 = wg; row0 < TTOK; row0 += 4 * nw) {
        f32x4 v[4][4];
#pragma unroll
        for (int k = 0; k < 4; ++k) {
            int row = row0 + k * nw; row = row < TTOK ? row : row0;
            const float* src = layer == 0 ? (row < SEQ ? p.x_prompt + (size_t)row * 1024 : p.x_sample + (size_t)(row - SEQ) * 1024) : WSP(p, float, WS_X1) + (size_t)row * 1024;
#pragma unroll
            for (int i = 0; i < 4; ++i) v[k][i] = *(const f32x4*)(src + i * 256 + lane * 4);
        }
#pragma unroll
        for (int k = 0; k < 4; ++k) {
            const int row = row0 + k * nw;
            float ss = 0.f;
#pragma unroll
            for (int i = 0; i < 4; ++i) ss += v[k][i][0] * v[k][i][0] + v[k][i][1] * v[k][i][1] + v[k][i][2] * v[k][i][2] + v[k][i][3] * v[k][i][3];
#pragma unroll
            for (int o = 32; o >= 1; o >>= 1) ss += __shfl_xor(ss, o);
            const float rstd = rsqrtf(ss * (1.0f / 1024.0f) + 1e-6f);
            if (row < TTOK) {
#pragma unroll
                for (int i = 0; i < 4; ++i) { const f32x4 y = v[k][i] * rstd * gv[i];
                    u32x2 o; o[0] = cvt_pk_bf16(y[0], y[1]); o[1] = cvt_pk_bf16(y[2], y[3]); *(u32x2*)(WSP(p, bf16_t, WS_HB) + (size_t)row * 1024 + i * 256 + lane * 4) = o; }
            }
        }
    }
}

struct KVf { bf16x8 k[4]; bf16x8 v[2][2]; };
struct StepGeom { int pat, ldil, single, j, qbA; };
__device__ __forceinline__ StepGeom step_geom(int s, int w) {
    StepGeom g;
    if (s < 6) { g.pat = 0; g.single = 0; g.j = s; g.qbA = 64 * w; }
    else if (s < 12) { g.pat = 1; g.single = 0; g.j = s - 6; g.qbA = 256 * (w >> 2) + (w & 3); }
    else if (s < 17) { g.pat = 2; g.single = 1; g.j = s - 12; g.qbA = w; }
    else { g.pat = 2; g.single = 1; g.j = s - 17; g.qbA = w + 8; }
    g.ldil = 2 * g.pat; return g;
}
__device__ __forceinline__ void load_kv(KVf& f, const bf16_t* __restrict__ kfh  , const bf16_t* __restrict__ vfh  , int s, int w, int T0) {
    const StepGeom g = step_geom(s, w);
    const int dil = 1 << g.ldil, qbase = T0 + g.qbA, vidx0 = qbase >> g.ldil, res = qbase & (dil - 1);
    int tile = (vidx0 >> 5) - 4 + g.j; tile = tile < 0 ? 0 : tile;
    const size_t off = (size_t)g.pat * ((size_t)768 * SEQ) + (size_t)(res * (512 >> g.ldil) + tile) * 2048;
    const bf16_t* kp = kfh + off; const bf16_t* vp = vfh + off;
#pragma unroll
    for (int s4 = 0; s4 < 4; ++s4) f.k[s4] = *(const bf16x8*)(kp + 512 * s4);
#pragma unroll
    for (int mt = 0; mt < 2; ++mt)
#pragma unroll
        for (int s2 = 0; s2 < 2; ++s2) f.v[mt][s2] = *(const bf16x8*)(vp + (mt * 2 + s2) * 512);
}
template <bool MASK>
__device__ __forceinline__ void attn_tile(const KVf& f, const bf16x8 (&qf)[4], f32x16& O0, f32x16& O1, float& den, float dsl, float base, int kk0, int vidx0, int c, int hh) {
    f32x16 S;
#pragma unroll
    for (int r = 0; r < 16; ++r) S[r] = fmaf(dsl, (float)((r & 3) + 8 * (r >> 2)), base);
#pragma unroll
    for (int s = 0; s < 4; ++s) S = __builtin_amdgcn_mfma_f32_32x32x16_bf16(f.k[s], qf[s], S, 0, 0, 0);
#pragma unroll
    for (int r = 0; r < 16; ++r) {
        float pv = __builtin_amdgcn_exp2f(S[r]);
        if (MASK) { const int kk = kk0 + (r & 3) + 8 * (r >> 2) + 4 * hh; const int dd = c - kk; const bool valid = (dd >= 0) && (dd <= 128) && (vidx0 + kk >= 0); pv = valid ? pv : 0.f; }
        den += pv; S[r] = pv;
    }
#pragma unroll
    for (int s2 = 0; s2 < 2; ++s2) {
        u32x4 pw;
#pragma unroll
        for (int j = 0; j < 4; ++j) pw[j] = cvt_pk_bf16(S[8 * s2 + 2 * j], S[8 * s2 + 2 * j + 1]);
        const bf16x8 pf = __builtin_bit_cast(bf16x8, pw);
        O0 = __builtin_amdgcn_mfma_f32_32x32x16_bf16(f.v[0][s2], pf, O0, 0, 0, 0);
        O1 = __builtin_amdgcn_mfma_f32_32x32x16_bf16(f.v[1][s2], pf, O1, 0, 0, 0);
    }
}

__device__ void attn_item(const Params& p, int layer, int sb, int h, float* accL, float Mref2) {
    const int tid = opaque_tid(), w = tid >> 6, lane = tid & 63, c = lane & 31, hh = lane >> 5;
    const int T0 = sb * 512;
    const float sl2 = exp2f(-8.0f * (float)(h + 1) / 12.0f) * LOG2E;
    const bf16_t* __restrict__ P = WSP(p, bf16_t, WS_P);
    const bf16_t* __restrict__ qbasep = P + 768 + h * 64 + 8 * hh;
    const bf16_t* __restrict__ kfh = WSP(p, bf16_t, WS_KF) + (size_t)h * (512 * 2048) + lane * 8;
    const bf16_t* __restrict__ vfh = WSP(p, bf16_t, WS_VT1) + (size_t)h * (512 * 2048) + lane * 8;
    KVf f0, f1;
    bf16x8 qa[4], qb_[4];
    f32x16 A0, A1, B0, B1; float denA = 0.f, denB = 0.f;
#pragma unroll
    for (int r = 0; r < 16; ++r) { A0[r] = 0.f; A1[r] = 0.f; B0[r] = 0.f; B1[r] = 0.f; }
#define LOAD_Q(S_) { const StepGeom gq = step_geom((S_), w); const bf16_t* qp = qbasep + (size_t)(T0 + gq.qbA + (c << gq.ldil)) * PROJ; \
        _Pragma("unroll") for (int s4 = 0; s4 < 4; ++s4) qa[s4] = *(const bf16x8*)(qp + 16 * s4); \
        if (!gq.single) { const bf16_t* qp2 = qp + (size_t)(32 << gq.ldil) * PROJ; _Pragma("unroll") for (int s4 = 0; s4 < 4; ++s4) qb_[s4] = *(const bf16x8*)(qp2 + 16 * s4); } }
#define FLUSH(O0_, O1_, DEN_, QB_) { \
        const float dt = (DEN_) + __shfl_xor((DEN_), 32); \
        float* arow = accL + ((QB_) + (c << g.ldil)) * 65; \
        if (g.pat == 0) { \
            _Pragma("unroll") for (int r = 0; r < 16; ++r) { const int d = (r & 3) + 8 * (r >> 2) + 4 * hh; arow[d] = O0_[r]; arow[32 + d] = O1_[r]; } \
            if (hh == 0) arow[64] = dt; \
        } else { \
            _Pragma("unroll") for (int r = 0; r < 16; ++r) { const int d = (r & 3) + 8 * (r >> 2) + 4 * hh; arow[d] += O0_[r]; arow[32 + d] += O1_[r]; } \
            if (hh == 0) arow[64] += dt; \
        } }
#define TILE(FA, Q_, O0_, O1_, DEN_, KT_, V0_) { \
        const int kk0 = -128 + 32 * (KT_); const float base = dsl * (float)(kk0 - c + 4 * hh) - Mref2; \
        if ((KT_) == 0 || (KT_) == 4 || (V0_) < 128) attn_tile<true>(FA, Q_, O0_, O1_, DEN_, dsl, base, kk0, (V0_), c, hh); \
        else attn_tile<false>(FA, Q_, O0_, O1_, DEN_, dsl, base, kk0, (V0_), c, hh); }
#define ATTN_STEP(FA, FC, S_) { \
        const int s_ = (S_); \
        if (s_ + 1 < 22) load_kv(FC, kfh, vfh, s_ + 1, w, T0); \
        const StepGeom g = step_geom(s_, w); \
        const int vA = (T0 + g.qbA) >> g.ldil; \
        const float dsl = sl2 * (float)(1 << g.ldil); \
        if (g.j <= 4) { \
            if (g.j == 0) { _Pragma("unroll") for (int r = 0; r < 16; ++r) { A0[r] = 0.f; A1[r] = 0.f; } denA = 0.f; } \
            TILE(FA, qa, A0, A1, denA, g.j, vA); \
            if (g.j == 4) FLUSH(A0, A1, denA, g.qbA); \
        } \
        if (!g.single && g.j >= 1) { \
            if (g.j == 1) { _Pragma("unroll") for (int r = 0; r < 16; ++r) { B0[r] = 0.f; B1[r] = 0.f; } denB = 0.f; } \
            TILE(FA, qb_, B0, B1, denB, g.j - 1, vA + 32); \
            if (g.j == 5) FLUSH(B0, B1, denB, g.qbA + (32 << g.ldil)); \
        } \
        if (g.single ? (g.j == 4) : (g.j == 5)) { \
            if (s_ + 1 < 22) LOAD_Q(s_ + 1); \
            if (s_ != 16) __syncthreads(); \
        } }
    LOAD_Q(0);
    load_kv(f0, kfh, vfh, 0, w, T0);
#pragma unroll 1
    for (int s = 0; s < 22; s += 2) {
        ATTN_STEP(f0, f1, s);
        ATTN_STEP(f1, f0, s + 1);
    }
#undef ATTN_STEP
#undef TILE
#undef FLUSH
#undef LOAD_Q
    bf16_t* __restrict__ Gp = WSP(p, bf16_t, WS_G);
#pragma unroll 1
    for (int it = 0; it < 4; ++it) {
        unsigned zb[8];
#pragma unroll
        for (int j = 0; j < 8; ++j) { const int idx = tid + NTHREADS * (it * 8 + j); const int ql = idx >> 5, d2 = (idx & 31) * 2;
            zb[j] = *(const unsigned*)(P + (size_t)(T0 + ql) * PROJ + 3072 + h * 64 + d2); }
#pragma unroll
        for (int j = 0; j < 8; ++j) { const int idx = tid + NTHREADS * (it * 8 + j); const int ql = idx >> 5, d2 = (idx & 31) * 2;
            const float inv = 1.0f / accL[ql * 65 + 64];
            const float o0 = accL[ql * 65 + d2] * inv * silu(bflo(zb[j])), o1 = accL[ql * 65 + d2 + 1] * inv * silu(bfhi(zb[j]));
            *(unsigned*)(Gp + (size_t)(T0 + ql) * 1024 + 256 + h * 64 + d2) = cvt_pk_bf16(o0, o1); }
    }
    __syncthreads();
}

__device__ void sgu_item(const Params& p, int layer, int ch, int g, bf16_t* vnT  ) {
    const int tid = opaque_tid(), w = tid >> 6, lane = tid & 63, c = lane & 31, hh = lane >> 5;
    const int R0 = ch * 128;
    const bf16_t* __restrict__ P = WSP(p, bf16_t, WS_P);
    const float* sg = p.sgu_g + layer * 256;
    const int tt = w >> 1, dt = w & 1;
    const int t = 32 * tt + c;
    const float* wrow = p.w_sp + ((size_t)(layer * 4 + g) * 128 + t) * 128 + 8 * hh;
    u32x2 vv[16];
#pragma unroll
    for (int rr = 0; rr < 16; ++rr) vv[rr] = *(const u32x2*)(P + (size_t)(R0 + w * 16 + rr) * PROJ + 256 + lane * 4);
    f32x4 w0[8], w1[8];
#pragma unroll
    for (int ks = 0; ks < 8; ++ks) { if (ks <= 2 * tt + 1) { w0[ks] = *(const f32x4*)(wrow + 16 * ks); w1[ks] = *(const f32x4*)(wrow + 16 * ks + 4); } else { w0[ks] = (f32x4){0.f, 0.f, 0.f, 0.f}; w1[ks] = w0[ks]; } }
    const f32x4 gv = *(const f32x4*)(sg + g * 64 + (lane & 15) * 4);
#pragma unroll
    for (int rr = 0; rr < 16; ++rr) {
        const int row = w * 16 + rr;
        const float f0 = bflo(vv[rr][0]), f1 = bfhi(vv[rr][0]), f2 = bflo(vv[rr][1]), f3 = bfhi(vv[rr][1]);
        float ss = f0 * f0 + f1 * f1 + f2 * f2 + f3 * f3;
#pragma unroll
        for (int o = 32; o >= 1; o >>= 1) ss += __shfl_xor(ss, o);
        const float rstd = rsqrtf(ss * (1.0f / 256.0f) + 1e-6f);
        if ((lane >> 4) == g) {
            const int dl = (lane & 15) * 4;
            vnT[(dl + 0) * 136 + row] = f2bf(f0 * rstd * gv[0]); vnT[(dl + 1) * 136 + row] = f2bf(f1 * rstd * gv[1]);
            vnT[(dl + 2) * 136 + row] = f2bf(f2 * rstd * gv[2]); vnT[(dl + 3) * 136 + row] = f2bf(f3 * rstd * gv[3]);
        }
    }
    const float* bsp = p.b_sp + (size_t)(layer * 4 + g) * 128;
    const int colA = g * 64 + 32 * dt + c;
    bf16_t uav[16], zav[16]; float bv[16];
#pragma unroll
    for (int r = 0; r < 16; ++r) { const int tr = 32 * tt + (r & 3) + 8 * (r >> 2) + 4 * hh; const size_t row = (size_t)(R0 + tr);
        uav[r] = P[row * PROJ + colA]; zav[r] = P[row * PROJ + 512 + colA]; bv[r] = bsp[tr]; }
    __syncthreads();
    f32x16 acc;
#pragma unroll
    for (int r = 0; r < 16; ++r) acc[r] = 0.f;
#pragma unroll
    for (int ks = 0; ks < 8; ++ks) {
        if (ks <= 2 * tt + 1) {
            const int s0 = 16 * ks + 8 * hh;
            u32x4 aw;
            aw[0] = cvt_pk_bf16(s0 + 0 <= t ? w0[ks][0] : 0.f, s0 + 1 <= t ? w0[ks][1] : 0.f); aw[1] = cvt_pk_bf16(s0 + 2 <= t ? w0[ks][2] : 0.f, s0 + 3 <= t ? w0[ks][3] : 0.f);
            aw[2] = cvt_pk_bf16(s0 + 4 <= t ? w1[ks][0] : 0.f, s0 + 5 <= t ? w1[ks][1] : 0.f); aw[3] = cvt_pk_bf16(s0 + 6 <= t ? w1[ks][2] : 0.f, s0 + 7 <= t ? w1[ks][3] : 0.f);
            const bf16x8 bfrag = *(const bf16x8*)(vnT + (32 * dt + c) * 136 + s0);
            acc = __builtin_amdgcn_mfma_f32_32x32x16_bf16(__builtin_bit_cast(bf16x8, aw), bfrag, acc, 0, 0, 0);
        }
    }
    bf16_t* __restrict__ Gp = WSP(p, bf16_t, WS_G);
#pragma unroll
    for (int r = 0; r < 16; ++r) {
        const int tr = 32 * tt + (r & 3) + 8 * (r >> 2) + 4 * hh;
        Gp[(size_t)(R0 + tr) * 1024 + colA] = f2bf(bf2f(uav[r]) * (acc[r] + bv[r]) * silu(bf2f(zav[r])));
    }
    __syncthreads();
}

__device__ void sattn_item(const Params& p, int layer, int b, int h, float* part  , float Mref) {
    const int tid = opaque_tid();
    const float slope = exp2f(-8.0f * (float)(h + 1) / 12.0f);
    const size_t tok = (size_t)(SEQ + b);
    const bf16_t* __restrict__ P = WSP(p, bf16_t, WS_P);
    const float* ck = p.cache_k + ((size_t)(layer * NS + b) * CACHE) * 768 + h * 64;
    const float* cv = p.cache_v + ((size_t)(layer * NS + b) * CACHE) * 768 + h * 64;
    const float* nk = p.out + O_KS + ((size_t)(layer * NS + b)) * 768 + h * 64;
    const float* nv = p.out + O_VS + ((size_t)(layer * NS + b)) * 768 + h * 64;
    const int sub = tid & 15, grp = tid >> 4;
    f32x4 k4[13], v4[13];
#pragma unroll
    for (int it = 0; it < 13; ++it) {
        const int e = it * 32 + grp; const int ee = e < 387 ? e : 0; const int pat = ee >= 258 ? 2 : (ee >= 129 ? 1 : 0); const int j = ee - pat * 129; const int dist = j << (2 * pat);
        const float* kr = dist == 0 ? nk : ck + (size_t)(CACHE - dist) * 768;
        const float* vr = dist == 0 ? nv : cv + (size_t)(CACHE - dist) * 768;
        k4[it] = *(const f32x4*)(kr + sub * 4); v4[it] = *(const f32x4*)(vr + sub * 4);
    }
    f32x4 q4;
    { const u32x2 qv = *(const u32x2*)(P + tok * PROJ + 768 + h * 64 + sub * 4); q4[0] = bflo(qv[0]); q4[1] = bfhi(qv[0]); q4[2] = bflo(qv[1]); q4[3] = bfhi(qv[1]); }
    const float zbv = tid < 64 ? bf2f(P[tok * PROJ + 3072 + h * 64 + tid]) : 0.f;
    f32x4 acc = (f32x4){0.f, 0.f, 0.f, 0.f}; float den = 0.f;
#pragma unroll
    for (int it = 0; it < 13; ++it) {
        const int e = it * 32 + grp; const bool act = e < 387; const int ee = act ? e : 0; const int pat = ee >= 258 ? 2 : (ee >= 129 ? 1 : 0); const int j = ee - pat * 129; const int dist = j << (2 * pat);
        float d = q4[0] * k4[it][0] + q4[1] * k4[it][1] + q4[2] * k4[it][2] + q4[3] * k4[it][3];
        d += __shfl_xor(d, 1); d += __shfl_xor(d, 2); d += __shfl_xor(d, 4); d += __shfl_xor(d, 8);
        const float pe = act ? __builtin_amdgcn_exp2f(d - slope * LOG2E * (float)dist - Mref * LOG2E) : 0.f;
        acc += v4[it] * pe; den += pe;
    }
    *(f32x4*)(part + grp * 68 + sub * 4) = acc; if (sub == 0) part[grp * 68 + 64] = den;
    __syncthreads();
    if (tid < 64) {
        float num = 0.f, dn = 0.f;
#pragma unroll
        for (int k = 0; k < 32; ++k) { num += part[k * 68 + tid]; dn += part[k * 68 + 64]; }
        WSP(p, bf16_t, WS_G)[tok * 1024 + 256 + h * 64 + tid] = f2bf(num / dn * silu(zbv));
    }
    __syncthreads();
}

__device__ void ssgu_item(const Params& p, int layer) {
    const int tid = opaque_tid(), w = tid >> 6, lane = tid & 63;
    const float* sg = p.sgu_g + layer * 256;
    const bf16_t* __restrict__ P = WSP(p, bf16_t, WS_P);
    for (int rr = 0; rr < 4; ++rr) {
        const int b = w * 4 + rr; const size_t tok = (size_t)(SEQ + b);
        const u32x2 v = *(const u32x2*)(P + tok * PROJ + 256 + lane * 4);
        const u32x2 uav = *(const u32x2*)(P + tok * PROJ + lane * 4), zav = *(const u32x2*)(P + tok * PROJ + 512 + lane * 4);
        float f[4] = {bflo(v[0]), bfhi(v[0]), bflo(v[1]), bfhi(v[1])};
        float ss = f[0] * f[0] + f[1] * f[1] + f[2] * f[2] + f[3] * f[3];
#pragma unroll
        for (int o = 32; o >= 1; o >>= 1) ss += __shfl_xor(ss, o);
        const float rstd = rsqrtf(ss * (1.0f / 256.0f) + 1e-6f);
        const int g = lane >> 4;
        const float w00 = p.w_sp[(size_t)(layer * 4 + g) * 128 * 128], b0 = p.b_sp[(size_t)(layer * 4 + g) * 128];
        const float ua[4] = {bflo(uav[0]), bfhi(uav[0]), bflo(uav[1]), bfhi(uav[1])}, za[4] = {bflo(zav[0]), bfhi(zav[0]), bflo(zav[1]), bfhi(zav[1])};
        const f32x4 gv = *(const f32x4*)(sg + lane * 4);
        f32x4 vn; float o[4];
#pragma unroll
        for (int e = 0; e < 4; ++e) { vn[e] = f[e] * rstd * gv[e]; o[e] = ua[e] * (w00 * vn[e] + b0) * silu(za[e]); }
        *(f32x4*)(p.out + O_SG + ((size_t)(layer * NS + b)) * 256 + lane * 4) = vn;
        u32x2 go; go[0] = pk2(o[0], o[1]); go[1] = pk2(o[2], o[3]);
        *(u32x2*)(WSP(p, bf16_t, WS_G) + tok * 1024 + lane * 4) = go;
    }
    __syncthreads();
}

__global__ void __launch_bounds__(NTHREADS, 2) hymba_fwd(Params p) {
    extern __shared__ __attribute__((aligned(16))) unsigned char shm[];
    cg::grid_group grid = cg::this_grid();
    for (int i = 0; i < p.extra_syncs; ++i) grid.sync();
    const int G = gridDim.x, c = blockIdx.x;
    volatile LAS unsigned* xst = (volatile LAS unsigned*)((LAS unsigned char*)shm + LDS_CTL + 8);
    if (threadIdx.x == 0) { xst[0] = 0u; xst[1] = 0u; }
    __syncthreads();
    (void)xcd_barrier_post(WSP(p, unsigned, WS_BAR), xst);
    for (int step = 0; step < p.nsteps; ++step) {
        if (step > 0) { XcdBarrier xb; xb.bar = WSP(p, unsigned, WS_BAR); xb.x = xb_xcc_id(); xb.st = (volatile LAS unsigned*)((LAS unsigned char*)shm + LDS_CTL + 8); xcd_barrier(xb); }
        const int ph = (int)((p.sched >> (4 * step)) & 15ull);
        const int layer = ph >> 2, kind = ph & 3;
        if (kind == 0) {
            if (layer == 0) {
                { const int t0_ = opaque_tid(); if (c == 0 && t0_ < 256) WSP(p, int, WS_CTL)[t0_] = 0; }
                transpose_all(p, (float*)shm);
            }
            rmsnorm_rows(p, layer);
        } else if (kind == 1) {
            LAS unsigned char* lds = (LAS unsigned char*)shm;
            const bf16_t* W = WSP(p, bf16_t, WS_WINT) + (size_t)layer * PROJ * 1024;
            {
                pg8::Order S; S.nM = 65; S.nN = 12; S.nwg = 780; S.G = G; S.c = c; S.i0 = 0; S.Loff = 0; S.pm_add = 0; S.pn_skip_from = 9; S.pn_skip_by = 3;
                pg8::Gemm g; g.A = WSP(p, bf16_t, WS_HB); g.Bt = W; g.K = 1024;
                EpiIn E; E.P = WSP(p, bf16_t, WS_P); E.KF = WSP(p, bf16_t, WS_KF); E.qg = p.qg + layer * 64; E.kg = p.kg + layer * 64; E.outk_p = p.out + O_KP + (size_t)layer * CACHE * 768; E.outk_s = p.out + O_KS + (size_t)layer * NS * 768;
                pg8::gemm_phase<EpiIn>(lds, g, S, E);
            }
            {
                pg8::Order S; S.nM = 3; S.nN = 65; S.nwg = 195; S.G = G; S.c = c; S.i0 = c < 780 ? (780 - c + G - 1) / G : 0; S.Loff = 780; S.pm_add = 9; S.pn_skip_from = 1 << 30; S.pn_skip_by = 0;
                pg8::Gemm g; g.A = W; g.Bt = WSP(p, bf16_t, WS_HB); g.K = 1024;
                EpiV E; E.VT1 = WSP(p, bf16_t, WS_VT1); E.VT2 = WSP(p, bf16_t, WS_VT2); E.VT3 = WSP(p, bf16_t, WS_VT3); E.outv_p = p.out + O_VP + (size_t)layer * CACHE * 768; E.outv_s = p.out + O_VS + (size_t)layer * NS * 768;
                E.xb = lds + LDS_XB;
                pg8::gemm_phase<EpiV>(lds, g, S, E);
            }
        } else if (kind == 2) {
            float gq = 0.f, gk = 0.f;
            for (int i = 0; i < 64; ++i) { gq = fmaxf(gq, fabsf(p.qg[layer * 64 + i])); gk = fmaxf(gk, fabsf(p.kg[layer * 64 + i])); }
            const float Mref = 8.2f * gq * gk;
            int* ctr = WSP(p, int, WS_CTL) + step * 16;
            volatile int* slot = (volatile int*)(shm + LDS_CTL);
            int qsteal = 0;
            auto fetch = [&]() -> int {
                while (qsteal < 8) { const int q = (c + qsteal) & 7; const int idx = atomicAdd(ctr + q, 1); if (idx < 48) return q * 48 + idx; ++qsteal; }
                return 384 + atomicAdd(ctr + 8, 1);
            };
            if (threadIdx.x == 0) *slot = fetch();
            __syncthreads();
            int item = *slot;
            while (item < 1281) {
                __syncthreads();
                int nxt = 0;
                if (threadIdx.x == 0) nxt = fetch();
                if (item < 384) attn_item(p, layer, item & 31, item >> 5, (float*)shm, Mref * LOG2E);
                else if (item < 768) sattn_item(p, layer, (item - 384) / 12, (item - 384) % 12, (float*)shm, Mref);
                else if (item < 1280) sgu_item(p, layer, (item - 768) >> 2, (item - 768) & 3, (bf16_t*)shm);
                else ssgu_item(p, layer);
                if (threadIdx.x == 0) *slot = nxt;
                __syncthreads();
                item = *slot;
            }
        } else {
            LAS unsigned char* lds = (LAS unsigned char*)shm;
            pg8::Order S; S.nM = 64; S.nN = 4; S.nwg = 256; S.G = G; S.c = c; S.i0 = 0; S.Loff = 0; S.pm_add = 0; S.pn_skip_from = 1 << 30; S.pn_skip_by = 0;
            pg8::Gemm g; g.A = WSP(p, bf16_t, WS_G); g.Bt = WSP(p, bf16_t, WS_WOUTT) + (size_t)layer * 1024 * 1024; g.K = 1024;
            EpiOut E;
            if (layer == 0) { E.xin = p.x_prompt; E.xo = WSP(p, float, WS_X1); }
            else { E.xin = WSP(p, float, WS_X1); E.xo = p.out + O_YP; }
            pg8::gemm_phase<EpiOut>(lds, g, S, E);
            sample_outproj(p, layer);
        }
    }
}

#ifndef SINGLE_LAUNCH
#define SINGLE_LAUNCH 1
#endif
extern "C" void kernel_launch(void* const* d_in, const int* in_sizes, int n_in, void* d_out, int out_size, void* d_ws, size_t ws_size, hipStream_t stream) {
    static int grid = 0;
    if (grid == 0) {
        int dev = 0, cus = 0, per_cu = 0;
        hipGetDevice(&dev);
        hipDeviceGetAttribute(&cus, hipDeviceAttributeMultiprocessorCount, dev);
        if (hipFuncSetAttribute((const void*)hymba_fwd, hipFuncAttributeMaxDynamicSharedMemorySize, LDS_BYTES) != hipSuccess) { fprintf(stderr, "hipFuncSetAttribute failed\n"); grid = -1; return; }
        if (hipOccupancyMaxActiveBlocksPerMultiprocessor(&per_cu, (const void*)hymba_fwd, NTHREADS, LDS_BYTES) != hipSuccess || per_cu < 1) { fprintf(stderr, "occupancy query: %d\n", per_cu); per_cu = 1; }
        (void)hipGetLastError();
        if (per_cu > 1) per_cu = 1;
        grid = cus * per_cu;
    }
    if (grid < 0) return;
    Params p{};
    p.x_prompt = (const float*)d_in[0]; p.x_sample = (const float*)d_in[1]; p.cache_k = (const float*)d_in[2]; p.cache_v = (const float*)d_in[3];
    p.norm_g = (const float*)d_in[4]; p.w_in = (const float*)d_in[5]; p.sgu_g = (const float*)d_in[6]; p.w_sp = (const float*)d_in[7]; p.b_sp = (const float*)d_in[8];
    p.qg = (const float*)d_in[9]; p.kg = (const float*)d_in[10]; p.w_out = (const float*)d_in[11];
    p.out = (float*)d_out;
    p.ws = (unsigned char*)d_ws;
    if (ws_size < WS_END) { fprintf(stderr, "workspace too small\n"); return; }
#if SINGLE_LAUNCH
#ifndef PROBE_SCHED
#define PROBE_SCHED 0x76543210ull
#define PROBE_NSTEPS 8
#endif
#ifndef PROBE_SYNCS
#define PROBE_SYNCS 0
#endif
    p.sched = PROBE_SCHED; p.nsteps = PROBE_NSTEPS; p.extra_syncs = PROBE_SYNCS;
    (void)hipMemsetAsync((unsigned char*)d_ws + WS_BAR, 0, XCD_BAR_WORDS * sizeof(unsigned), stream);
    void* args[] = {&p};
    hipError_t e = hipLaunchCooperativeKernel((const void*)hymba_fwd, dim3(grid), dim3(NTHREADS), args, LDS_BYTES, stream);
    if (e != hipSuccess) fprintf(stderr, "cooperative launch failed: %s (grid %d)\n", hipGetErrorString(e), grid);
#else
    for (int ph = 0; ph < 8; ++ph) { p.sched = (unsigned long long)ph; p.nsteps = 1; p.extra_syncs = 0; hipLaunchKernelGGL(hymba_fwd, dim3(grid), dim3(NTHREADS), LDS_BYTES, stream, p); }
#endif
}
```

```cpp
#include <hip/hip_runtime.h>
#include <hip/hip_cooperative_groups.h>
#include <cstdio>
namespace cg = cooperative_groups;

#define LAS __attribute__((address_space(3)))
typedef unsigned short bf16_t;
typedef short bf16x8 __attribute__((ext_vector_type(8)));
typedef float f32x4 __attribute__((ext_vector_type(4)));
typedef float f32x16 __attribute__((ext_vector_type(16)));
typedef unsigned u32x2 __attribute__((ext_vector_type(2)));
typedef unsigned u32x4 __attribute__((ext_vector_type(4)));

constexpr int D_MODEL = 1024, SEQ = 16384, NS = 32, TTOK = SEQ + NS  , MPAD = 16640, PROJ = 3840, CACHE = 2048;
constexpr int NTHREADS = 512;
constexpr int LDS_BYTES = 150 * 1024;
constexpr int LDS_XB = 128 * 1024;
constexpr int LDS_CTL = 150 * 1024 - 16;
constexpr float LOG2E = 1.4426950408889634f;

constexpr size_t O_YP = 0, O_YS = 16777216, O_KP = O_YS + 32768, O_VP = O_KP + 3145728, O_KS = O_VP + 3145728, O_VS = O_KS + 49152, O_SG = O_VS + 49152;

struct Params {
    const float *x_prompt, *x_sample, *cache_k, *cache_v, *norm_g, *w_in, *sgu_g, *w_sp, *b_sp, *qg, *kg, *w_out;
    float* out;
    unsigned char* ws;
    unsigned long long sched;
    int nsteps, extra_syncs;
};
constexpr size_t al4k(size_t b) { return (b + 4095) & ~(size_t)4095; }
constexpr size_t WS_WINT = 0;
constexpr size_t WS_WOUTT = WS_WINT + al4k((size_t)2 * PROJ * 1024 * 2);
constexpr size_t WS_HB = WS_WOUTT + al4k((size_t)2 * 1024 * 1024 * 2);
constexpr size_t WS_P = WS_HB + al4k((size_t)MPAD * 1024 * 2);
constexpr size_t WS_VT1 = WS_P + al4k((size_t)MPAD * PROJ * 2);
constexpr size_t WS_VT2 = WS_VT1 + al4k((size_t)768 * SEQ * 2);
constexpr size_t WS_VT3 = WS_VT2 + al4k((size_t)768 * SEQ * 2);
constexpr size_t WS_G = WS_VT3 + al4k((size_t)768 * SEQ * 2);
constexpr size_t WS_X1 = WS_G + al4k((size_t)MPAD * 1024 * 2);
constexpr size_t WS_KF = WS_X1 + al4k((size_t)TTOK * 1024 * 4);
constexpr size_t WS_CTL = WS_KF + 3 * al4k((size_t)768 * SEQ * 2);
constexpr size_t WS_BAR = WS_CTL + 4096;
constexpr size_t WS_END = WS_BAR + 16384;
#define WSP(p, T, OFF) ((T*)((p).ws + (OFF)))

__device__ __forceinline__ bf16_t f2bf(float f) { unsigned u = __float_as_uint(f); u += 0x7FFFu + ((u >> 16) & 1u); return (bf16_t)(u >> 16); }
__device__ __forceinline__ unsigned pk2(float lo, float hi) { return (unsigned)f2bf(lo) | ((unsigned)f2bf(hi) << 16); }
__device__ __forceinline__ float bf2f(bf16_t b) { return __uint_as_float(((unsigned)b) << 16); }
__device__ __forceinline__ float bflo(unsigned u) { return __uint_as_float(u << 16); }
__device__ __forceinline__ float bfhi(unsigned u) { return __uint_as_float(u & 0xFFFF0000u); }
__device__ __forceinline__ int opaque_tid() { int t = threadIdx.x; asm volatile("" : "+v"(t)); return t; }
__device__ __forceinline__ float silu(float x) { return x * __builtin_amdgcn_rcpf(1.0f + __builtin_amdgcn_exp2f(-LOG2E * x)); }

#define XB_TMO      128
#define XB_XCNT(j)  (256  + 64 * (j))
#define XB_XSUB(j)  (1280 + 64 * (j))
#define XB_XGEN(j)  (2304 + 64 * (j))
#define XB_TOP      3328
#define XB_TOPGEN   3392
#define XCD_BAR_WORDS 3456
#define XB_SPIN_CAP (1u << 18)

__device__ __forceinline__ unsigned xb_ld(unsigned* p)              { return __hip_atomic_load(p, __ATOMIC_RELAXED, __HIP_MEMORY_SCOPE_AGENT); }
__device__ __forceinline__ unsigned xb_add(unsigned* p, unsigned v) { return __hip_atomic_fetch_add(p, v, __ATOMIC_RELAXED, __HIP_MEMORY_SCOPE_AGENT); }
__device__ __forceinline__ unsigned xb_xcc_id() { return (unsigned)__builtin_amdgcn_s_getreg((3 << 11) | 20) & 0xFu; }
#define XB_SPIN(cond, bar) do { unsigned _sp = 0; while (cond) { __builtin_amdgcn_s_sleep(1); \
    if ((++_sp & 255u) == 0u) { if (xb_ld(&(bar)[XB_TMO])) break; if (_sp > XB_SPIN_CAP) { atomicAdd(&(bar)[XB_TMO], 1u); break; } } } } while (0)

struct XcdBarrier {
    unsigned* bar; unsigned x;
    volatile LAS unsigned* st;
};

__device__ __forceinline__ XcdBarrier xcd_barrier_post(unsigned* bar, volatile LAS unsigned* st) {
    XcdBarrier b; b.bar = bar; b.x = xb_xcc_id(); b.st = st;
    if (threadIdx.x == 0) (void)xb_add(&bar[XB_XCNT(b.x)], 1u);
    return b;
}
__device__ __forceinline__ void xcd_barrier_complete(unsigned* bar, unsigned x, unsigned& nloc, unsigned& nx) {
    const unsigned G = gridDim.x * gridDim.y * gridDim.z;
    unsigned sum, cnt, mine, sp = 0u;
    for (;;) {
        sum = 0u; cnt = 0u; mine = 0u;
#pragma unroll
        for (unsigned j = 0; j < 16; ++j) { const unsigned c = xb_ld(&bar[XB_XCNT(j)]); sum += c; cnt += (c > 0u) ? 1u : 0u; mine = (j == x) ? c : mine; }
        if (sum == G) break;
        __builtin_amdgcn_s_sleep(1);
        if ((++sp & 255u) == 0u) { if (xb_ld(&bar[XB_TMO])) break; if (sp > XB_SPIN_CAP) { atomicAdd(&bar[XB_TMO], 1u); break; } }
    }
    nloc = mine > 0u ? mine : 1u; nx = cnt > 0u ? cnt : 1u;
}

__device__ __forceinline__ void xcd_barrier(const XcdBarrier& b) {
    asm volatile("s_waitcnt vmcnt(0)" ::: "memory");
    __syncthreads();
    if (threadIdx.x == 0) {
        unsigned* bar = b.bar;
        __builtin_amdgcn_s_waitcnt(0);
        unsigned nloc = b.st[0], nx = b.st[1];
        if (nloc == 0u) { xcd_barrier_complete(bar, b.x, nloc, nx); b.st[0] = nloc; b.st[1] = nx; }
        const unsigned old = xb_add(&bar[XB_XSUB(b.x)], 1u);
        const unsigned gen = old / nloc;
        if (old + 1u == (gen + 1u) * nloc) {
            __builtin_amdgcn_fence(__ATOMIC_RELEASE, "agent");
            asm volatile("s_waitcnt vmcnt(0)" ::: "memory");
            const unsigned og = xb_add(&bar[XB_TOP], 1u);
            const unsigned tg = og / nx;
            if (og + 1u == (tg + 1u) * nx) xb_add(&bar[XB_TOPGEN], 1u);
            else XB_SPIN(xb_ld(&bar[XB_TOPGEN]) == tg, bar);
            __builtin_amdgcn_fence(__ATOMIC_ACQUIRE, "agent");
            xb_add(&bar[XB_XGEN(b.x)], 1u);
            asm volatile("s_waitcnt vmcnt(0)" ::: "memory");
        } else {
            XB_SPIN(xb_ld(&bar[XB_XGEN(b.x)]) == gen, bar);
            __builtin_amdgcn_fence(__ATOMIC_ACQUIRE, "agent");
            asm volatile("s_waitcnt vmcnt(0)" ::: "memory");
        }
    }
    __syncthreads();
}


namespace pg8 {
constexpr int BM = 256, BK = 64, HALF = 128, HTB = HALF * BK * 2, STAGE_BYTES = 8 * HTB, NXCD = 8, WGM = 8;
__device__ __forceinline__ int lds_byte(int r, int c) { const int st = (r >> 4) * 2 + (c >> 5), rr = r & 15, cc = c & 31, ob = rr * 64 + cc * 2; return st * 1024 + (ob ^ (((ob >> 9) & 1) << 5)); }
__device__ __forceinline__ void stage_rc(int b, int& R, int& C) { const int st = b / 1024, sb = b % 1024, swz = sb ^ (((sb >> 9) & 1) << 5); R = (st >> 1) * 16 + swz / 64; C = (st & 1) * 32 + (swz % 64) / 2; }
struct Unit { int pm, pn; };
struct Gemm { const bf16_t* A; const bf16_t* Bt; int K; };

struct Order {
    int nM, nN, nwg, G, c, i0, Loff, pm_add, pn_skip_from, pn_skip_by;
    __device__ bool next(int i, Unit& u) const {
        const long L = (long)(i + i0) * G + c - Loff; if (L < 0 || L >= nwg) return false;
        int wgid = (int)L; { const int q = nwg / NXCD, r = nwg % NXCD, xcd = wgid % NXCD, off = wgid / NXCD; wgid = (xcd < r ? xcd * (q + 1) : r * (q + 1) + (xcd - r) * q) + off; }
        const int nig = WGM * nN, gid = wgid / nig, fm = gid * WGM, gsz = (nM - fm) < WGM ? (nM - fm) : WGM;
        u.pm = fm + ((wgid % nig) % gsz) + pm_add; int pn = (wgid % nig) / gsz; if (pn >= pn_skip_from) pn += pn_skip_by; u.pn = pn; return true;
    }
};

template <class Epi>
__device__ __forceinline__ void gemm_phase(LAS unsigned char* lds, const Gemm g, const Order& S, const Epi& E) {
    const int tid = opaque_tid(), wid = __builtin_amdgcn_readfirstlane(tid >> 6), lane = tid & 63, wr = wid >> 2, wc = wid & 3, fr = lane & 15, fq = lane >> 4;
    const int K = g.K, nt = K / BK;
    unsigned voffA[2], voffB[2];
#pragma unroll
    for (int i = 0; i < 2; ++i) { int R, C; stage_rc(tid * 16 + i * 8192, R, C); const int Rb = Epi::BPERM ? (64 * (R >> 5) + 16 * ((R >> 2) & 3) + 4 * ((R >> 4) & 1) + (R & 3)) : R;
        voffA[i] = (unsigned)(R * K + C) * 2u; voffB[i] = (unsigned)(Rb * K + C) * 2u; }
    const size_t kstep = (size_t)(BK * 2);
    const size_t hstep = (size_t)HALF * K * 2;
    const size_t hstepB = Epi::BPERM ? (size_t)8 * K * 2 : hstep;
    const size_t tstep = 2 * hstep;
    const unsigned ldsw = (unsigned)wid * 1024u;
    const int aoff = lds_byte(wr * 64 + fr, fq * 8), boff = lds_byte(wc * 32 + fr, fq * 8);
#define PG8_SA(b, h) (((b) * 2 + (h)) * HTB)
#define PG8_SB(b, h) ((4 + (b) * 2 + (h)) * HTB)
#define PG8_STAGE(bufoff, gbase, voff) do { _Pragma("unroll") for (int _i = 0; _i < 2; ++_i) \
        __builtin_amdgcn_global_load_lds((const unsigned*)((const char*)(gbase) + (voff)[_i]), (LAS unsigned*)(lds + (bufoff) + ldsw + _i * 8192), 16, 0, 0); } while (0)
#define PG8_LDA(dst, b, h) do { _Pragma("unroll") for (int m = 0; m < 4; ++m) _Pragma("unroll") for (int k = 0; k < 2; ++k) dst[m][k] = *(const LAS bf16x8*)(lds + PG8_SA(b, h) + aoff + m * 2048 + k * 1024); } while (0)
#define PG8_LDB(dst, b, h) do { _Pragma("unroll") for (int n = 0; n < 2; ++n) _Pragma("unroll") for (int k = 0; k < 2; ++k) dst[n][k] = *(const LAS bf16x8*)(lds + PG8_SB(b, h) + boff + n * 2048 + k * 1024); } while (0)
#define PG8_MMA(ai, bj, At, Bt) do { __builtin_amdgcn_s_setprio(1); _Pragma("unroll") for (int m = 0; m < 4; ++m) _Pragma("unroll") for (int n = 0; n < 2; ++n) _Pragma("unroll") for (int k = 0; k < 2; ++k) \
        acc[ai][bj][m][n] = __builtin_amdgcn_mfma_f32_16x16x32_bf16(Bt[n][k], At[m][k], acc[ai][bj][m][n], 0, 0, 0); __builtin_amdgcn_s_setprio(0); } while (0)
#define PG8_WAIT_V(n) asm volatile("s_waitcnt vmcnt(" #n ")" ::: "memory")
#define PG8_WAIT_L(n) asm volatile("s_waitcnt lgkmcnt(" #n ")" ::: "memory")
#define PG8_BAR __builtin_amdgcn_s_barrier()
#define PG8_SCHED __builtin_amdgcn_sched_barrier(0)
    Unit cur, nxt; int ui = 0;
    if (!S.next(0, cur)) return;
    f32x4 acc[2][2][4][2];
#pragma unroll
    for (int a = 0; a < 2; ++a)
#pragma unroll
        for (int b = 0; b < 2; ++b)
#pragma unroll
            for (int m = 0; m < 4; ++m)
#pragma unroll
                for (int n = 0; n < 2; ++n) acc[a][b][m][n] = (f32x4){0.f, 0.f, 0.f, 0.f};
    bf16x8 At[4][2], B0[2][2], B1[2][2];
    const char* cA = (const char*)g.A + (size_t)cur.pm * tstep; const char* cB = (const char*)g.Bt + (size_t)cur.pn * tstep;
    PG8_STAGE(PG8_SB(0, 0), cB, voffB); PG8_STAGE(PG8_SA(0, 0), cA, voffA); PG8_STAGE(PG8_SB(0, 1), cB + hstepB, voffB); PG8_STAGE(PG8_SA(0, 1), cA + hstep, voffA);
    if (wr == 1) PG8_BAR;
    PG8_WAIT_V(4); PG8_BAR;
    PG8_STAGE(PG8_SB(1, 0), cB + kstep, voffB); PG8_STAGE(PG8_SA(1, 0), cA + kstep, voffA); PG8_STAGE(PG8_SB(1, 1), cB + hstepB + kstep, voffB);
    PG8_WAIT_V(6); PG8_BAR;
    for (;;) {
        const bool has_next = S.next(ui + 1, nxt);
        const char* nA = has_next ? (const char*)g.A + (size_t)nxt.pm * tstep : cA; const char* nB = has_next ? (const char*)g.Bt + (size_t)nxt.pn * tstep : cB;
        for (int t = 0; t < nt; t += 2) {
            const bool last = (t == nt - 2);
            const char* a1 = cA + (size_t)(t + 1) * kstep;
            const char* a2 = last ? nA : cA + (size_t)(t + 2) * kstep; const char* b2 = last ? nB : cB + (size_t)(t + 2) * kstep;
            const char* a3 = a2 + kstep; const char* b3 = b2 + kstep;
            PG8_LDB(B0, 0, 0); PG8_SCHED; PG8_LDA(At, 0, 0); PG8_STAGE(PG8_SA(1, 1), a1 + hstep, voffA);
            PG8_WAIT_L(8); PG8_BAR; PG8_WAIT_L(0); PG8_MMA(0, 0, At, B0); PG8_BAR; PG8_SCHED;
            PG8_LDB(B1, 0, 1); PG8_STAGE(PG8_SB(0, 0), b2, voffB);
            PG8_BAR; PG8_WAIT_L(0); PG8_MMA(0, 1, At, B1); PG8_BAR;
            PG8_LDA(At, 0, 1); PG8_STAGE(PG8_SA(0, 0), a2, voffA);
            PG8_BAR; PG8_WAIT_L(0); PG8_MMA(1, 0, At, B0); PG8_BAR; PG8_SCHED;
            PG8_STAGE(PG8_SB(0, 1), b2 + hstepB, voffB);
            PG8_WAIT_V(6); PG8_BAR; PG8_MMA(1, 1, At, B1); PG8_BAR;
            PG8_LDB(B0, 1, 0); PG8_SCHED; PG8_LDA(At, 1, 0); PG8_STAGE(PG8_SA(0, 1), a2 + hstep, voffA);
            PG8_WAIT_L(8); PG8_BAR; PG8_WAIT_L(0); PG8_MMA(0, 0, At, B0); PG8_BAR; PG8_SCHED;
            PG8_LDB(B1, 1, 1); PG8_STAGE(PG8_SB(1, 0), b3, voffB);
            PG8_BAR; PG8_WAIT_L(0); PG8_MMA(0, 1, At, B1); PG8_BAR;
            PG8_LDA(At, 1, 1); PG8_STAGE(PG8_SA(1, 0), a3, voffA);
            PG8_BAR; PG8_WAIT_L(0); PG8_MMA(1, 0, At, B0); PG8_BAR; PG8_SCHED;
            PG8_STAGE(PG8_SB(1, 1), b3 + hstepB, voffB);
            PG8_WAIT_V(6); PG8_BAR; PG8_MMA(1, 1, At, B1); PG8_BAR;
        }
        E(acc, cur, wr, wc, fr, fq);
        if (!has_next) break;
#pragma unroll
        for (int a = 0; a < 2; ++a)
#pragma unroll
            for (int b = 0; b < 2; ++b)
#pragma unroll
                for (int m = 0; m < 4; ++m)
#pragma unroll
                    for (int n = 0; n < 2; ++n) acc[a][b][m][n] = (f32x4){0.f, 0.f, 0.f, 0.f};
        cur = nxt; cA = nA; cB = nB; ++ui;
    }
    PG8_WAIT_V(0);
    if (wr == 0) PG8_BAR;
    PG8_BAR;
#undef PG8_SA
#undef PG8_SB
#undef PG8_STAGE
#undef PG8_LDA
#undef PG8_LDB
#undef PG8_MMA
#undef PG8_WAIT_V
#undef PG8_WAIT_L
#undef PG8_BAR
#undef PG8_SCHED
}
}
using pg8::Unit;

__device__ __forceinline__ unsigned cvt_pk_bf16(float lo, float hi) { unsigned r; asm("v_cvt_pk_bf16_f32 %0, %1, %2" : "=v"(r) : "v"(lo), "v"(hi)); return r; }

struct EpiIn {
    static constexpr bool BPERM = true;
    bf16_t* P; bf16_t* KF; const float* qg; const float* kg; float* outk_p; float* outk_s;
    __device__ __forceinline__ void operator()(const f32x4 (&acc)[2][2][4][2], const Unit& u, int wr, int wc, int fr, int fq) const {
        const int pn = u.pn;
        const int kind = (pn >= 3 && pn < 6) ? 1 : ((pn >= 6 && pn < 9) ? 2 : 0);
        const int col0 = pn * 256 + wc * 64 + 16 * fq;
        f32x4 gv[2][2];
        const float* gp = kind == 1 ? qg : kg;
#pragma unroll
        for (int bj = 0; bj < 2; ++bj)
#pragma unroll
            for (int n = 0; n < 2; ++n) {
                if (kind) { gv[bj][n] = *(const f32x4*)(gp + 16 * fq + 8 * bj + 4 * n); if (kind == 1) gv[bj][n] = gv[bj][n] * (0.125f * LOG2E); }
                else gv[bj][n] = (f32x4){1.f, 1.f, 1.f, 1.f};
            }
#pragma unroll
        for (int ai = 0; ai < 2; ++ai)
#pragma unroll
            for (int m = 0; m < 4; ++m) {
                const int r = u.pm * 256 + ai * 128 + wr * 64 + m * 16 + fr;
                float rstd = 1.0f;
                if (kind) {
                    float ss = 0.f;
#pragma unroll
                    for (int bj = 0; bj < 2; ++bj)
#pragma unroll
                        for (int n = 0; n < 2; ++n)
#pragma unroll
                            for (int e = 0; e < 4; ++e) ss += acc[ai][bj][m][n][e] * acc[ai][bj][m][n][e];
                    ss += __shfl_xor(ss, 16); ss += __shfl_xor(ss, 32);
                    rstd = rsqrtf(ss * (1.0f / 64.0f) + 1e-6f);
                }
                f32x4 v[2][2];
#pragma unroll
                for (int bj = 0; bj < 2; ++bj)
#pragma unroll
                    for (int n = 0; n < 2; ++n) v[bj][n] = acc[ai][bj][m][n] * gv[bj][n] * rstd;
                if (r < TTOK) {
                    u32x4 o0, o1;
                    o0[0] = cvt_pk_bf16(v[0][0][0], v[0][0][1]); o0[1] = cvt_pk_bf16(v[0][0][2], v[0][0][3]); o0[2] = cvt_pk_bf16(v[0][1][0], v[0][1][1]); o0[3] = cvt_pk_bf16(v[0][1][2], v[0][1][3]);
                    o1[0] = cvt_pk_bf16(v[1][0][0], v[1][0][1]); o1[1] = cvt_pk_bf16(v[1][0][2], v[1][0][3]); o1[2] = cvt_pk_bf16(v[1][1][0], v[1][1][1]); o1[3] = cvt_pk_bf16(v[1][1][2], v[1][1][3]);
                    if (kind != 2) { bf16_t* dst = P + (size_t)r * PROJ + col0; *(u32x4*)dst = o0; *(u32x4*)(dst + 8) = o1; }
                    else if (r < SEQ) {
                        const int hk = (pn - 6) * 4 + wc;
#pragma unroll
                        for (int pat = 0; pat < 3; ++pat) {
                            const int ldil = 2 * pat, sidx = r >> ldil, res = r & ((1 << ldil) - 1);
                            bf16_t* dst = KF + (size_t)pat * ((size_t)768 * SEQ) + (size_t)(hk * 512 + res * (512 >> ldil) + (sidx >> 5)) * 2048 + fq * 512 + (sidx & 31) * 8;
                            *(u32x4*)dst = o0; *(u32x4*)(dst + 256) = o1;
                        }
                    }
                    if (kind == 2 && r >= SEQ - CACHE) {
                        float* od = r < SEQ ? outk_p + (size_t)(r - (SEQ - CACHE)) * 768 + (col0 - 1536) : outk_s + (size_t)(r - SEQ) * 768 + (col0 - 1536);
                        *(f32x4*)(od) = v[0][0]; *(f32x4*)(od + 4) = v[0][1]; *(f32x4*)(od + 8) = v[1][0]; *(f32x4*)(od + 12) = v[1][1];
                    }
                }
            }
    }
};
struct EpiV {
    static constexpr bool BPERM = true;
    bf16_t *VT1, *VT2, *VT3; float* outv_p; float* outv_s; LAS unsigned char* xb;
    __device__ __forceinline__ void operator()(const f32x4 (&acc)[2][2][4][2], const Unit& u, int wr, int wc, int fr, int fq) const {
        LAS unsigned char* xw = xb + (wr * 4 + wc) * 2304;
        const int tw = u.pn * 256 + wc * 64;
        const int t0 = tw + 16 * fq;
        const int lane = fr + 16 * fq;
#pragma unroll
        for (int ai = 0; ai < 2; ++ai)
#pragma unroll
            for (int m = 0; m < 4; ++m) {
                const int fbase = u.pm * 256 + ai * 128 + wr * 64 + m * 16 - 2304;
                const int fv = fbase + fr;
                if (tw < SEQ) {
                    u32x4 o0, o1;
                    o0[0] = cvt_pk_bf16(acc[ai][0][m][0][0], acc[ai][0][m][0][1]); o0[1] = cvt_pk_bf16(acc[ai][0][m][0][2], acc[ai][0][m][0][3]);
                    o0[2] = cvt_pk_bf16(acc[ai][0][m][1][0], acc[ai][0][m][1][1]); o0[3] = cvt_pk_bf16(acc[ai][0][m][1][2], acc[ai][0][m][1][3]);
                    o1[0] = cvt_pk_bf16(acc[ai][1][m][0][0], acc[ai][1][m][0][1]); o1[1] = cvt_pk_bf16(acc[ai][1][m][0][2], acc[ai][1][m][0][3]);
                    o1[2] = cvt_pk_bf16(acc[ai][1][m][1][0], acc[ai][1][m][1][1]); o1[3] = cvt_pk_bf16(acc[ai][1][m][1][2], acc[ai][1][m][1][3]);
                    const int hv = fv >> 6, dv = fv & 63, fo = (dv >> 5) * 1024 + (dv & 31) * 8;
                    {
                        u32x4 p0, p1; p0[0] = o0[0]; p0[1] = o0[1]; p0[2] = o1[0]; p0[3] = o1[1]; p1[0] = o0[2]; p1[1] = o0[3]; p1[2] = o1[2]; p1[3] = o1[3];
                        bf16_t* d1 = VT1 + (size_t)(hv * 512 + (t0 >> 5)) * 2048 + ((t0 >> 4) & 1) * 512 + fo;
                        *(u32x4*)d1 = p0; *(u32x4*)(d1 + 256) = p1;
                    }
#pragma unroll
                    for (int e = 0; e < 4; ++e) {
                        u32x2 w2; w2[0] = cvt_pk_bf16(acc[ai][0][m][0][e], acc[ai][0][m][1][e]); w2[1] = cvt_pk_bf16(acc[ai][1][m][0][e], acc[ai][1][m][1][e]);
                        const int si = t0 >> 2, qq = (si >> 2) & 3;
                        *(u32x2*)(VT2 + (size_t)(hv * 512 + e * 128 + (si >> 5)) * 2048 + ((si >> 4) & 1) * 512 + fo + (qq & 1) * 256 + (qq >> 1) * 4) = w2;
                    }
                    *(LAS u32x4*)(xw + fr * 144 + fq * 32) = o0; *(LAS u32x4*)(xw + fr * 144 + fq * 32 + 16) = o1;
#pragma unroll
                    for (int k = 0; k < 4; ++k) {
                        const int id = lane + 64 * k, f2 = id & 15, rho = id >> 4;
                        const LAS unsigned short* srcp = (const LAS unsigned short*)(xw + f2 * 144 + rho * 2);
                        const unsigned a0 = srcp[0], a1 = srcp[16], a2 = srcp[32], a3 = srcp[48];
                        u32x2 w3; w3[0] = a0 | (a1 << 16); w3[1] = a2 | (a3 << 16);
                        const int fv2 = fbase + f2, h2 = fv2 >> 6, d2 = fv2 & 63, si = tw >> 4, qq = (si >> 2) & 3;
                        *(u32x2*)(VT3 + (size_t)(h2 * 512 + rho * 32 + (si >> 5)) * 2048 + ((si >> 4) & 1) * 512 + (d2 >> 5) * 1024 + (d2 & 31) * 8 + (qq & 1) * 256 + (qq >> 1) * 4) = w3;
                    }
                    if (tw >= SEQ - CACHE) {
#pragma unroll
                        for (int bj = 0; bj < 2; ++bj)
#pragma unroll
                            for (int n = 0; n < 2; ++n)
#pragma unroll
                                for (int e = 0; e < 4; ++e) outv_p[(size_t)(t0 + 8 * bj + 4 * n + e - (SEQ - CACHE)) * 768 + fv] = acc[ai][bj][m][n][e];
                    }
                } else if (t0 < TTOK) {
#pragma unroll
                    for (int bj = 0; bj < 2; ++bj)
#pragma unroll
                        for (int n = 0; n < 2; ++n)
#pragma unroll
                            for (int e = 0; e < 4; ++e) outv_s[(size_t)(t0 + 8 * bj + 4 * n + e - SEQ) * 768 + fv] = acc[ai][bj][m][n][e];
                }
            }
    }
};
struct EpiOut {
    static constexpr bool BPERM = true;
    const float* xin; float* xo;
    __device__ __forceinline__ void operator()(const f32x4 (&acc)[2][2][4][2], const Unit& u, int wr, int wc, int fr, int fq) const {
        const int c0 = u.pn * 256 + wc * 64 + 16 * fq;
#pragma unroll
        for (int ai = 0; ai < 2; ++ai)
#pragma unroll
            for (int m = 0; m < 4; ++m) {
                const int r = u.pm * 256 + ai * 128 + wr * 64 + m * 16 + fr;
                const float* xi = xin + (size_t)r * 1024 + c0; float* xop = xo + (size_t)r * 1024 + c0;
                f32x4 x[2][2];
#pragma unroll
                for (int bj = 0; bj < 2; ++bj)
#pragma unroll
                    for (int n = 0; n < 2; ++n) x[bj][n] = *(const f32x4*)(xi + 8 * bj + 4 * n);
#pragma unroll
                for (int bj = 0; bj < 2; ++bj)
#pragma unroll
                    for (int n = 0; n < 2; ++n) *(f32x4*)(xop + 8 * bj + 4 * n) = x[bj][n] + acc[ai][bj][m][n];
            }
    }
};
__device__ void sample_outproj(const Params& p, int layer) {
    const int tid = opaque_tid(), dotid = tid >> 2, sub = tid & 3, row = dotid >> 2;
    const float* xi = layer == 0 ? p.x_sample : WSP(p, float, WS_X1) + (size_t)SEQ * 1024;
    float* xo = layer == 0 ? WSP(p, float, WS_X1) + (size_t)SEQ * 1024 : p.out + O_YS;
    for (int cb = blockIdx.x; cb < 256; cb += gridDim.x) {
        const int col = 4 * cb + (dotid & 3);
        const bf16_t* gp = WSP(p, bf16_t, WS_G) + (size_t)(SEQ + row) * 1024 + sub * 256;
        const bf16_t* wp = WSP(p, bf16_t, WS_WOUTT) + (size_t)layer * 1024 * 1024 + (size_t)col * 1024 + sub * 256;
        float a = 0.f;
#pragma unroll 8
        for (int i = 0; i < 32; ++i) {
            const u32x4 gv = *(const u32x4*)(gp + 8 * i), wv = *(const u32x4*)(wp + 8 * i);
#pragma unroll
            for (int j = 0; j < 4; ++j) a += bflo(gv[j]) * bflo(wv[j]) + bfhi(gv[j]) * bfhi(wv[j]);
        }
        a += __shfl_xor(a, 1); a += __shfl_xor(a, 2);
        if (sub == 0) xo[(size_t)row * 1024 + col] = xi[(size_t)row * 1024 + col] + a;
    }
}
__device__ __forceinline__ void tp_src(const Params& p, int t, const float*& src, bf16_t*& dst, int& N, int& kb, int& nb) {
    const int l = t / 1216; int tt = t - l * 1216;
    if (tt < 960) { src = p.w_in + (size_t)l * 1024 * PROJ; dst = WSP(p, bf16_t, WS_WINT) + (size_t)l * PROJ * 1024; N = PROJ; }
    else { tt -= 960; src = p.w_out + (size_t)l * 1024 * 1024; dst = WSP(p, bf16_t, WS_WOUTT) + (size_t)l * 1024 * 1024; N = 1024; }
    const int tilesN = N / 64; kb = (tt / tilesN) * 64; nb = (tt % tilesN) * 64;
}
__device__ void transpose_all(const Params& p, float* tile) {
    const int tid = opaque_tid(), G = gridDim.x;
    const int n = tid & 63, k0 = tid >> 6;
    float v[8];
    int t = blockIdx.x;
    if (t < 2432) { const float* src; bf16_t* dst; int N, kb, nb; tp_src(p, t, src, dst, N, kb, nb);
#pragma unroll
        for (int i = 0; i < 8; ++i) v[i] = src[(size_t)(kb + k0 + 8 * i) * N + nb + n]; }
    for (; t < 2432; t += G) {
        const float* src; bf16_t* dst; int N, kb, nb; tp_src(p, t, src, dst, N, kb, nb);
#pragma unroll
        for (int i = 0; i < 8; ++i) tile[(k0 + 8 * i) * 65 + n] = v[i];
        if (t + G < 2432) { const float* src2; bf16_t* dst2; int N2, kb2, nb2; tp_src(p, t + G, src2, dst2, N2, kb2, nb2);
#pragma unroll
            for (int i = 0; i < 8; ++i) v[i] = src2[(size_t)(kb2 + k0 + 8 * i) * N2 + nb2 + n]; }
        __syncthreads();
        {
            const int kp = (tid & 31) * 2, n0 = tid >> 5;
#pragma unroll
            for (int i = 0; i < 4; ++i) { const int nn = n0 + 16 * i; *(unsigned*)(dst + (size_t)(nb + nn) * 1024 + kb + kp) = cvt_pk_bf16(tile[kp * 65 + nn], tile[(kp + 1) * 65 + nn]); }
        }
        __syncthreads();
    }
}

__device__ void rmsnorm_rows(const Params& p, int layer) {
    const int tid = opaque_tid(), lane = tid & 63, wg = blockIdx.x * 8 + (tid >> 6), nw = gridDim.x * 8;
    const float* g = p.norm_g + layer * 1024;
    f32x4 gv[4];
#pragma unroll
    for (int i = 0; i < 4; ++i) gv[i] = *(const f32x4*)(g + i * 256 + lane * 4);
    for (int row0 = wg; row0 < TTOK; row0 += 4 * nw) {
        f32x4 v[4][4];
#pragma unroll
        for (int k = 0; k < 4; ++k) {
            int row = row0 + k * nw; row = row < TTOK ? row : row0;
            const float* src = layer == 0 ? (row < SEQ ? p.x_prompt + (size_t)row * 1024 : p.x_sample + (size_t)(row - SEQ) * 1024) : WSP(p, float, WS_X1) + (size_t)row * 1024;
#pragma unroll
            for (int i = 0; i < 4; ++i) v[k][i] = *(const f32x4*)(src + i * 256 + lane * 4);
        }
#pragma unroll
        for (int k = 0; k < 4; ++k) {
            const int row = row0 + k * nw;
            float ss = 0.f;
#pragma unroll
            for (int i = 0; i < 4; ++i) ss += v[k][i][0] * v[k][i][0] + v[k][i][1] * v[k][i][1] + v[k][i][2] * v[k][i][2] + v[k][i][3] * v[k][i][3];
#pragma unroll
            for (int o = 32; o >= 1; o >>= 1) ss += __shfl_xor(ss, o);
            const float rstd = rsqrtf(ss * (1.0f / 1024.0f) + 1e-6f);
            if (row < TTOK) {
#pragma unroll
                for (int i = 0; i < 4; ++i) { const f32x4 y = v[k][i] * rstd * gv[i];
                    u32x2 o; o[0] = cvt_pk_bf16(y[0], y[1]); o[1] = cvt_pk_bf16(y[2], y[3]); *(u32x2*)(WSP(p, bf16_t, WS_HB) + (size_t)row * 1024 + i * 256 + lane * 4) = o; }
            }
        }
    }
}

struct KVf { bf16x8 k[4]; bf16x8 v[2][2]; };
struct StepGeom { int pat, ldil, single, j, qbA; };
__device__ __forceinline__ StepGeom step_geom(int s, int w) {
    StepGeom g;
    if (s < 6) { g.pat = 0; g.single = 0; g.j = s; g.qbA = 64 * w; }
    else if (s < 12) { g.pat = 1; g.single = 0; g.j = s - 6; g.qbA = 256 * (w >> 2) + (w & 3); }
    else if (s < 17) { g.pat = 2; g.single = 1; g.j = s - 12; g.qbA = w; }
    else { g.pat = 2; g.single = 1; g.j = s - 17; g.qbA = w + 8; }
    g.ldil = 2 * g.pat; return g;
}
__device__ __forceinline__ void load_kv(KVf& f, const bf16_t* __restrict__ kfh  , const bf16_t* __restrict__ vfh  , int s, int w, int T0) {
    const StepGeom g = step_geom(s, w);
    const int dil = 1 << g.ldil, qbase = T0 + g.qbA, vidx0 = qbase >> g.ldil, res = qbase & (dil - 1);
    int tile = (vidx0 >> 5) - 4 + g.j; tile = tile < 0 ? 0 : tile;
    const size_t off = (size_t)g.pat * ((size_t)768 * SEQ) + (size_t)(res * (512 >> g.ldil) + tile) * 2048;
    const bf16_t* kp = kfh + off; const bf16_t* vp = vfh + off;
#pragma unroll
    for (int s4 = 0; s4 < 4; ++s4) f.k[s4] = *(const bf16x8*)(kp + 512 * s4);
#pragma unroll
    for (int mt = 0; mt < 2; ++mt)
#pragma unroll
        for (int s2 = 0; s2 < 2; ++s2) f.v[mt][s2] = *(const bf16x8*)(vp + (mt * 2 + s2) * 512);
}
template <bool MASK>
__device__ __forceinline__ void attn_tile(const KVf& f, const bf16x8 (&qf)[4], f32x16& O0, f32x16& O1, float& den, float dsl, float base, int kk0, int vidx0, int c, int hh) {
    f32x16 S;
#pragma unroll
    for (int r = 0; r < 16; ++r) S[r] = fmaf(dsl, (float)((r & 3) + 8 * (r >> 2)), base);
#pragma unroll
    for (int s = 0; s < 4; ++s) S = __builtin_amdgcn_mfma_f32_32x32x16_bf16(f.k[s], qf[s], S, 0, 0, 0);
#pragma unroll
    for (int r = 0; r < 16; ++r) {
        float pv = __builtin_amdgcn_exp2f(S[r]);
        if (MASK) { const int kk = kk0 + (r & 3) + 8 * (r >> 2) + 4 * hh; const int dd = c - kk; const bool valid = (dd >= 0) && (dd <= 128) && (vidx0 + kk >= 0); pv = valid ? pv : 0.f; }
        den += pv; S[r] = pv;
    }
#pragma unroll
    for (int s2 = 0; s2 < 2; ++s2) {
        u32x4 pw;
#pragma unroll
        for (int j = 0; j < 4; ++j) pw[j] = cvt_pk_bf16(S[8 * s2 + 2 * j], S[8 * s2 + 2 * j + 1]);
        const bf16x8 pf = __builtin_bit_cast(bf16x8, pw);
        O0 = __builtin_amdgcn_mfma_f32_32x32x16_bf16(f.v[0][s2], pf, O0, 0, 0, 0);
        O1 = __builtin_amdgcn_mfma_f32_32x32x16_bf16(f.v[1][s2], pf, O1, 0, 0, 0);
    }
}

__device__ void attn_item(const Params& p, int layer, int sb, int h, float* accL, float Mref2) {
    const int tid = opaque_tid(), w = __builtin_amdgcn_readfirstlane(tid >> 6), lane = tid & 63, c = lane & 31, hh = lane >> 5;
    const int T0 = sb * 512;
    const float sl2 = exp2f(-8.0f * (float)(h + 1) / 12.0f) * LOG2E;
    const bf16_t* __restrict__ P = WSP(p, bf16_t, WS_P);
    const bf16_t* __restrict__ qbasep = P + 768 + h * 64 + 8 * hh;
    const bf16_t* __restrict__ kfh = WSP(p, bf16_t, WS_KF) + (size_t)h * (512 * 2048) + lane * 8;
    const bf16_t* __restrict__ vfh = WSP(p, bf16_t, WS_VT1) + (size_t)h * (512 * 2048) + lane * 8;
    KVf f0, f1;
    bf16x8 qa[4], qb_[4];
    f32x16 A0, A1, B0, B1; float denA = 0.f, denB = 0.f;
#pragma unroll
    for (int r = 0; r < 16; ++r) { A0[r] = 0.f; A1[r] = 0.f; B0[r] = 0.f; B1[r] = 0.f; }
#define LOAD_Q(S_) { const StepGeom gq = step_geom((S_), w); const bf16_t* qp = qbasep + (size_t)(T0 + gq.qbA + (c << gq.ldil)) * PROJ; \
        _Pragma("unroll") for (int s4 = 0; s4 < 4; ++s4) qa[s4] = *(const bf16x8*)(qp + 16 * s4); \
        if (!gq.single) { const bf16_t* qp2 = qp + (size_t)(32 << gq.ldil) * PROJ; _Pragma("unroll") for (int s4 = 0; s4 < 4; ++s4) qb_[s4] = *(const bf16x8*)(qp2 + 16 * s4); } }
#define FLUSH(O0_, O1_, DEN_, QB_) { \
        const float dt = (DEN_) + __shfl_xor((DEN_), 32); \
        const int row_ = (QB_) + (c << g.ldil); \
        float* arow = accL + (row_ ^ ((row_ >> 5) & 15)) * 65; \
        if (g.pat == 0) { \
            _Pragma("unroll") for (int r = 0; r < 16; ++r) { const int d = (r & 3) + 8 * (r >> 2) + 4 * hh; arow[d] = O0_[r]; arow[32 + d] = O1_[r]; } \
            if (hh == 0) arow[64] = dt; \
        } else { \
            _Pragma("unroll") for (int r = 0; r < 16; ++r) { const int d = (r & 3) + 8 * (r >> 2) + 4 * hh; arow[d] += O0_[r]; arow[32 + d] += O1_[r]; } \
            if (hh == 0) arow[64] += dt; \
        } }
#define TILE(FA, Q_, O0_, O1_, DEN_, KT_, V0_) { \
        const int kk0 = -128 + 32 * (KT_); const float base = dsl * (float)(kk0 - c + 4 * hh) - Mref2; \
        if ((KT_) == 0 || (KT_) == 4 || (V0_) < 128) attn_tile<true>(FA, Q_, O0_, O1_, DEN_, dsl, base, kk0, (V0_), c, hh); \
        else attn_tile<false>(FA, Q_, O0_, O1_, DEN_, dsl, base, kk0, (V0_), c, hh); }
#define ATTN_STEP(FA, FC, S_) { \
        const int s_ = (S_); \
        if (s_ + 1 < 22) load_kv(FC, kfh, vfh, s_ + 1, w, T0); \
        const StepGeom g = step_geom(s_, w); \
        const int vA = (T0 + g.qbA) >> g.ldil; \
        const float dsl = sl2 * (float)(1 << g.ldil); \
        if (g.j <= 4) { \
            if (g.j == 0) { _Pragma("unroll") for (int r = 0; r < 16; ++r) { A0[r] = 0.f; A1[r] = 0.f; } denA = 0.f; } \
            TILE(FA, qa, A0, A1, denA, g.j, vA); \
            if (g.j == 4) FLUSH(A0, A1, denA, g.qbA); \
        } \
        if (!g.single && g.j >= 1) { \
            if (g.j == 1) { _Pragma("unroll") for (int r = 0; r < 16; ++r) { B0[r] = 0.f; B1[r] = 0.f; } denB = 0.f; } \
            TILE(FA, qb_, B0, B1, denB, g.j - 1, vA + 32); \
            if (g.j == 5) FLUSH(B0, B1, denB, g.qbA + (32 << g.ldil)); \
        } \
        if (g.single ? (g.j == 4) : (g.j == 5)) { \
            if (s_ + 1 < 22) LOAD_Q(s_ + 1); \
            if (s_ != 16) __syncthreads(); \
        } }
    LOAD_Q(0);
    load_kv(f0, kfh, vfh, 0, w, T0);
#pragma unroll 1
    for (int s = 0; s < 22; s += 2) {
        ATTN_STEP(f0, f1, s);
        ATTN_STEP(f1, f0, s + 1);
    }
#undef ATTN_STEP
#undef TILE
#undef FLUSH
#undef LOAD_Q
    bf16_t* __restrict__ Gp = WSP(p, bf16_t, WS_G);
#pragma unroll 1
    for (int it = 0; it < 4; ++it) {
        unsigned zb[8];
#pragma unroll
        for (int j = 0; j < 8; ++j) { const int idx = tid + NTHREADS * (it * 8 + j); const int ql = idx >> 5, d2 = (idx & 31) * 2;
            zb[j] = *(const unsigned*)(P + (size_t)(T0 + ql) * PROJ + 3072 + h * 64 + d2); }
#pragma unroll
        for (int j = 0; j < 8; ++j) { const int idx = tid + NTHREADS * (it * 8 + j); const int ql = idx >> 5, d2 = (idx & 31) * 2;
            const float* ar = accL + (ql ^ ((ql >> 5) & 15)) * 65;
            const float inv = __builtin_amdgcn_rcpf(ar[64]);
            const float o0 = ar[d2] * inv * silu(bflo(zb[j])), o1 = ar[d2 + 1] * inv * silu(bfhi(zb[j]));
            *(unsigned*)(Gp + (size_t)(T0 + ql) * 1024 + 256 + h * 64 + d2) = cvt_pk_bf16(o0, o1); }
    }
    __syncthreads();
}

__device__ void sgu_item(const Params& p, int layer, int ch, int g, bf16_t* vnT  ) {
    const int tid = opaque_tid(), w = __builtin_amdgcn_readfirstlane(tid >> 6), lane = tid & 63, c = lane & 31, hh = lane >> 5;
    const int R0 = ch * 128;
    const bf16_t* __restrict__ P = WSP(p, bf16_t, WS_P);
    const float* sg = p.sgu_g + layer * 256;
    const int tt = w >> 1, dt = w & 1;
    const int t = 32 * tt + c;
    const float* wrow = p.w_sp + ((size_t)(layer * 4 + g) * 128 + t) * 128 + 8 * hh;
    u32x2 vv[16];
#pragma unroll
    for (int rr = 0; rr < 16; ++rr) vv[rr] = *(const u32x2*)(P + (size_t)(R0 + w * 16 + rr) * PROJ + 256 + lane * 4);
    f32x4 w0[8], w1[8];
#pragma unroll
    for (int ks = 0; ks < 8; ++ks) { if (ks <= 2 * tt + 1) { w0[ks] = *(const f32x4*)(wrow + 16 * ks); w1[ks] = *(const f32x4*)(wrow + 16 * ks + 4); } else { w0[ks] = (f32x4){0.f, 0.f, 0.f, 0.f}; w1[ks] = w0[ks]; } }
    const f32x4 gv = *(const f32x4*)(sg + g * 64 + (lane & 15) * 4);
#pragma unroll
    for (int rr = 0; rr < 16; ++rr) {
        const int row = w * 16 + rr;
        const float f0 = bflo(vv[rr][0]), f1 = bfhi(vv[rr][0]), f2 = bflo(vv[rr][1]), f3 = bfhi(vv[rr][1]);
        float ss = f0 * f0 + f1 * f1 + f2 * f2 + f3 * f3;
#pragma unroll
        for (int o = 32; o >= 1; o >>= 1) ss += __shfl_xor(ss, o);
        const float rstd = rsqrtf(ss * (1.0f / 256.0f) + 1e-6f);
        if ((lane >> 4) == g) {
            const int dl = (lane & 15) * 4;
            vnT[(dl + 0) * 136 + row] = f2bf(f0 * rstd * gv[0]); vnT[(dl + 1) * 136 + row] = f2bf(f1 * rstd * gv[1]);
            vnT[(dl + 2) * 136 + row] = f2bf(f2 * rstd * gv[2]); vnT[(dl + 3) * 136 + row] = f2bf(f3 * rstd * gv[3]);
        }
    }
    const float* bsp = p.b_sp + (size_t)(layer * 4 + g) * 128;
    const int colA = g * 64 + 32 * dt + c;
    bf16_t uav[16], zav[16]; float bv[16];
#pragma unroll
    for (int r = 0; r < 16; ++r) { const int tr = 32 * tt + (r & 3) + 8 * (r >> 2) + 4 * hh; const size_t row = (size_t)(R0 + tr);
        uav[r] = P[row * PROJ + colA]; zav[r] = P[row * PROJ + 512 + colA]; bv[r] = bsp[tr]; }
    __syncthreads();
    f32x16 acc;
#pragma unroll
    for (int r = 0; r < 16; ++r) acc[r] = 0.f;
#pragma unroll
    for (int ks = 0; ks < 8; ++ks) {
        if (ks <= 2 * tt + 1) {
            const int s0 = 16 * ks + 8 * hh;
            u32x4 aw;
            aw[0] = cvt_pk_bf16(s0 + 0 <= t ? w0[ks][0] : 0.f, s0 + 1 <= t ? w0[ks][1] : 0.f); aw[1] = cvt_pk_bf16(s0 + 2 <= t ? w0[ks][2] : 0.f, s0 + 3 <= t ? w0[ks][3] : 0.f);
            aw[2] = cvt_pk_bf16(s0 + 4 <= t ? w1[ks][0] : 0.f, s0 + 5 <= t ? w1[ks][1] : 0.f); aw[3] = cvt_pk_bf16(s0 + 6 <= t ? w1[ks][2] : 0.f, s0 + 7 <= t ? w1[ks][3] : 0.f);
            const bf16x8 bfrag = *(const bf16x8*)(vnT + (32 * dt + c) * 136 + s0);
            acc = __builtin_amdgcn_mfma_f32_32x32x16_bf16(__builtin_bit_cast(bf16x8, aw), bfrag, acc, 0, 0, 0);
        }
    }
    bf16_t* __restrict__ Gp = WSP(p, bf16_t, WS_G);
#pragma unroll
    for (int r = 0; r < 16; ++r) {
        const int tr = 32 * tt + (r & 3) + 8 * (r >> 2) + 4 * hh;
        Gp[(size_t)(R0 + tr) * 1024 + colA] = f2bf(bf2f(uav[r]) * (acc[r] + bv[r]) * silu(bf2f(zav[r])));
    }
    __syncthreads();
}

__device__ void sattn_item(const Params& p, int layer, int b, int h, float* part  , float Mref) {
    const int tid = opaque_tid();
    const float slope = exp2f(-8.0f * (float)(h + 1) / 12.0f);
    const size_t tok = (size_t)(SEQ + b);
    const bf16_t* __restrict__ P = WSP(p, bf16_t, WS_P);
    const float* ck = p.cache_k + ((size_t)(layer * NS + b) * CACHE) * 768 + h * 64;
    const float* cv = p.cache_v + ((size_t)(layer * NS + b) * CACHE) * 768 + h * 64;
    const float* nk = p.out + O_KS + ((size_t)(layer * NS + b)) * 768 + h * 64;
    const float* nv = p.out + O_VS + ((size_t)(layer * NS + b)) * 768 + h * 64;
    const int sub = tid & 15, grp = tid >> 4;
    f32x4 k4[13], v4[13];
#pragma unroll
    for (int it = 0; it < 13; ++it) {
        const int e = it * 32 + grp; const int ee = e < 387 ? e : 0; const int pat = ee >= 258 ? 2 : (ee >= 129 ? 1 : 0); const int j = ee - pat * 129; const int dist = j << (2 * pat);
        const float* kr = dist == 0 ? nk : ck + (size_t)(CACHE - dist) * 768;
        const float* vr = dist == 0 ? nv : cv + (size_t)(CACHE - dist) * 768;
        k4[it] = *(const f32x4*)(kr + sub * 4); v4[it] = *(const f32x4*)(vr + sub * 4);
    }
    f32x4 q4;
    { const u32x2 qv = *(const u32x2*)(P + tok * PROJ + 768 + h * 64 + sub * 4); q4[0] = bflo(qv[0]); q4[1] = bfhi(qv[0]); q4[2] = bflo(qv[1]); q4[3] = bfhi(qv[1]); }
    const float zbv = tid < 64 ? bf2f(P[tok * PROJ + 3072 + h * 64 + tid]) : 0.f;
    f32x4 acc = (f32x4){0.f, 0.f, 0.f, 0.f}; float den = 0.f;
#pragma unroll
    for (int it = 0; it < 13; ++it) {
        const int e = it * 32 + grp; const bool act = e < 387; const int ee = act ? e : 0; const int pat = ee >= 258 ? 2 : (ee >= 129 ? 1 : 0); const int j = ee - pat * 129; const int dist = j << (2 * pat);
        float d = q4[0] * k4[it][0] + q4[1] * k4[it][1] + q4[2] * k4[it][2] + q4[3] * k4[it][3];
        d += __shfl_xor(d, 1); d += __shfl_xor(d, 2); d += __shfl_xor(d, 4); d += __shfl_xor(d, 8);
        const float pe = act ? __builtin_amdgcn_exp2f(d - slope * LOG2E * (float)dist - Mref * LOG2E) : 0.f;
        acc += v4[it] * pe; den += pe;
    }
    *(f32x4*)(part + grp * 68 + sub * 4) = acc; if (sub == 0) part[grp * 68 + 64] = den;
    __syncthreads();
    if (tid < 64) {
        float num = 0.f, dn = 0.f;
#pragma unroll
        for (int k = 0; k < 32; ++k) { num += part[k * 68 + tid]; dn += part[k * 68 + 64]; }
        WSP(p, bf16_t, WS_G)[tok * 1024 + 256 + h * 64 + tid] = f2bf(num * __builtin_amdgcn_rcpf(dn) * silu(zbv));
    }
    __syncthreads();
}

__device__ void ssgu_item(const Params& p, int layer) {
    const int tid = opaque_tid(), w = tid >> 6, lane = tid & 63;
    const float* sg = p.sgu_g + layer * 256;
    const bf16_t* __restrict__ P = WSP(p, bf16_t, WS_P);
    for (int rr = 0; rr < 4; ++rr) {
        const int b = w * 4 + rr; const size_t tok = (size_t)(SEQ + b);
        const u32x2 v = *(const u32x2*)(P + tok * PROJ + 256 + lane * 4);
        const u32x2 uav = *(const u32x2*)(P + tok * PROJ + lane * 4), zav = *(const u32x2*)(P + tok * PROJ + 512 + lane * 4);
        float f[4] = {bflo(v[0]), bfhi(v[0]), bflo(v[1]), bfhi(v[1])};
        float ss = f[0] * f[0] + f[1] * f[1] + f[2] * f[2] + f[3] * f[3];
#pragma unroll
        for (int o = 32; o >= 1; o >>= 1) ss += __shfl_xor(ss, o);
        const float rstd = rsqrtf(ss * (1.0f / 256.0f) + 1e-6f);
        const int g = lane >> 4;
        const float w00 = p.w_sp[(size_t)(layer * 4 + g) * 128 * 128], b0 = p.b_sp[(size_t)(layer * 4 + g) * 128];
        const float ua[4] = {bflo(uav[0]), bfhi(uav[0]), bflo(uav[1]), bfhi(uav[1])}, za[4] = {bflo(zav[0]), bfhi(zav[0]), bflo(zav[1]), bfhi(zav[1])};
        const f32x4 gv = *(const f32x4*)(sg + lane * 4);
        f32x4 vn; float o[4];
#pragma unroll
        for (int e = 0; e < 4; ++e) { vn[e] = f[e] * rstd * gv[e]; o[e] = ua[e] * (w00 * vn[e] + b0) * silu(za[e]); }
        *(f32x4*)(p.out + O_SG + ((size_t)(layer * NS + b)) * 256 + lane * 4) = vn;
        u32x2 go; go[0] = pk2(o[0], o[1]); go[1] = pk2(o[2], o[3]);
        *(u32x2*)(WSP(p, bf16_t, WS_G) + tok * 1024 + lane * 4) = go;
    }
    __syncthreads();
}

__global__ void __launch_bounds__(NTHREADS, 2) hymba_fwd(Params p) {
    extern __shared__ __attribute__((aligned(16))) unsigned char shm[];
    cg::grid_group grid = cg::this_grid();
    for (int i = 0; i < p.extra_syncs; ++i) grid.sync();
    const int G = gridDim.x, c = blockIdx.x;
    volatile LAS unsigned* xst = (volatile LAS unsigned*)((LAS unsigned char*)shm + LDS_CTL + 8);
    if (threadIdx.x == 0) { xst[0] = 0u; xst[1] = 0u; }
    __syncthreads();
    (void)xcd_barrier_post(WSP(p, unsigned, WS_BAR), xst);
    for (int step = 0; step < p.nsteps; ++step) {
        if (step > 0) { XcdBarrier xb; xb.bar = WSP(p, unsigned, WS_BAR); xb.x = xb_xcc_id(); xb.st = (volatile LAS unsigned*)((LAS unsigned char*)shm + LDS_CTL + 8); xcd_barrier(xb); }
        const int ph = (int)((p.sched >> (4 * step)) & 15ull);
        const int layer = ph >> 2, kind = ph & 3;
        if (kind == 0) {
            if (layer == 0) {
                { const int t0_ = opaque_tid(); if (c == 0 && t0_ < 256) WSP(p, int, WS_CTL)[t0_] = 0; }
                transpose_all(p, (float*)shm);
            }
            rmsnorm_rows(p, layer);
        } else if (kind == 1) {
            LAS unsigned char* lds = (LAS unsigned char*)shm;
            const bf16_t* W = WSP(p, bf16_t, WS_WINT) + (size_t)layer * PROJ * 1024;
            {
                pg8::Order S; S.nM = 65; S.nN = 12; S.nwg = 780; S.G = G; S.c = c; S.i0 = 0; S.Loff = 0; S.pm_add = 0; S.pn_skip_from = 9; S.pn_skip_by = 3;
                pg8::Gemm g; g.A = WSP(p, bf16_t, WS_HB); g.Bt = W; g.K = 1024;
                EpiIn E; E.P = WSP(p, bf16_t, WS_P); E.KF = WSP(p, bf16_t, WS_KF); E.qg = p.qg + layer * 64; E.kg = p.kg + layer * 64; E.outk_p = p.out + O_KP + (size_t)layer * CACHE * 768; E.outk_s = p.out + O_KS + (size_t)layer * NS * 768;
                pg8::gemm_phase<EpiIn>(lds, g, S, E);
            }
            {
                pg8::Order S; S.nM = 3; S.nN = 65; S.nwg = 195; S.G = G; S.c = c; S.i0 = c < 780 ? (780 - c + G - 1) / G : 0; S.Loff = 780; S.pm_add = 9; S.pn_skip_from = 1 << 30; S.pn_skip_by = 0;
                pg8::Gemm g; g.A = W; g.Bt = WSP(p, bf16_t, WS_HB); g.K = 1024;
                EpiV E; E.VT1 = WSP(p, bf16_t, WS_VT1); E.VT2 = WSP(p, bf16_t, WS_VT2); E.VT3 = WSP(p, bf16_t, WS_VT3); E.outv_p = p.out + O_VP + (size_t)layer * CACHE * 768; E.outv_s = p.out + O_VS + (size_t)layer * NS * 768;
                E.xb = lds + LDS_XB;
                pg8::gemm_phase<EpiV>(lds, g, S, E);
            }
        } else if (kind == 2) {
            float gq = 0.f, gk = 0.f;
            for (int i = 0; i < 64; ++i) { gq = fmaxf(gq, fabsf(p.qg[layer * 64 + i])); gk = fmaxf(gk, fabsf(p.kg[layer * 64 + i])); }
            const float Mref = 8.2f * gq * gk;
            int* ctr = WSP(p, int, WS_CTL) + step * 16;
            volatile int* slot = (volatile int*)(shm + LDS_CTL);
            int qsteal = 0;
            auto fetch = [&]() -> int {
                while (qsteal < 8) { const int q = (c + qsteal) & 7; const int idx = atomicAdd(ctr + q, 1); if (idx < 48) return q * 48 + idx; ++qsteal; }
                return 384 + atomicAdd(ctr + 8, 1);
            };
            if (threadIdx.x == 0) *slot = fetch();
            __syncthreads();
            int item = *slot;
            while (item < 1281) {
                __syncthreads();
                int nxt = 0;
                if (threadIdx.x == 0) nxt = fetch();
                if (item < 384) attn_item(p, layer, item & 31, item >> 5, (float*)shm, Mref * LOG2E);
                else if (item < 768) sattn_item(p, layer, (item - 384) / 12, (item - 384) % 12, (float*)shm, Mref);
                else if (item < 1280) sgu_item(p, layer, (item - 768) >> 2, (item - 768) & 3, (bf16_t*)shm);
                else ssgu_item(p, layer);
                if (threadIdx.x == 0) *slot = nxt;
                __syncthreads();
                item = *slot;
            }
        } else {
            LAS unsigned char* lds = (LAS unsigned char*)shm;
            pg8::Order S; S.nM = 64; S.nN = 4; S.nwg = 256; S.G = G; S.c = c; S.i0 = 0; S.Loff = 0; S.pm_add = 0; S.pn_skip_from = 1 << 30; S.pn_skip_by = 0;
            pg8::Gemm g; g.A = WSP(p, bf16_t, WS_G); g.Bt = WSP(p, bf16_t, WS_WOUTT) + (size_t)layer * 1024 * 1024; g.K = 1024;
            EpiOut E;
            if (layer == 0) { E.xin = p.x_prompt; E.xo = WSP(p, float, WS_X1); }
            else { E.xin = WSP(p, float, WS_X1); E.xo = p.out + O_YP; }
            pg8::gemm_phase<EpiOut>(lds, g, S, E);
            sample_outproj(p, layer);
        }
    }
}

#ifndef SINGLE_LAUNCH
#define SINGLE_LAUNCH 1
#endif
extern "C" void kernel_launch(void* const* d_in, const int* in_sizes, int n_in, void* d_out, int out_size, void* d_ws, size_t ws_size, hipStream_t stream) {
    static int grid = 0;
    if (grid == 0) {
        int dev = 0, cus = 0, per_cu = 0;
        hipGetDevice(&dev);
        hipDeviceGetAttribute(&cus, hipDeviceAttributeMultiprocessorCount, dev);
        if (hipFuncSetAttribute((const void*)hymba_fwd, hipFuncAttributeMaxDynamicSharedMemorySize, LDS_BYTES) != hipSuccess) { fprintf(stderr, "hipFuncSetAttribute failed\n"); grid = -1; return; }
        if (hipOccupancyMaxActiveBlocksPerMultiprocessor(&per_cu, (const void*)hymba_fwd, NTHREADS, LDS_BYTES) != hipSuccess || per_cu < 1) { fprintf(stderr, "occupancy query: %d\n", per_cu); per_cu = 1; }
        (void)hipGetLastError();
        if (per_cu > 1) per_cu = 1;
        grid = cus * per_cu;
    }
    if (grid < 0) return;
    Params p{};
    p.x_prompt = (const float*)d_in[0]; p.x_sample = (const float*)d_in[1]; p.cache_k = (const float*)d_in[2]; p.cache_v = (const float*)d_in[3];
    p.norm_g = (const float*)d_in[4]; p.w_in = (const float*)d_in[5]; p.sgu_g = (const float*)d_in[6]; p.w_sp = (const float*)d_in[7]; p.b_sp = (const float*)d_in[8];
    p.qg = (const float*)d_in[9]; p.kg = (const float*)d_in[10]; p.w_out = (const float*)d_in[11];
    p.out = (float*)d_out;
    p.ws = (unsigned char*)d_ws;
    if (ws_size < WS_END) { fprintf(stderr, "workspace too small\n"); return; }
#if SINGLE_LAUNCH
#ifndef PROBE_SCHED
#define PROBE_SCHED 0x76543210ull
#define PROBE_NSTEPS 8
#endif
#ifndef PROBE_SYNCS
#define PROBE_SYNCS 0
#endif
    p.sched = PROBE_SCHED; p.nsteps = PROBE_NSTEPS; p.extra_syncs = PROBE_SYNCS;
    (void)hipMemsetAsync((unsigned char*)d_ws + WS_BAR, 0, XCD_BAR_WORDS * sizeof(unsigned), stream);
    void* args[] = {&p};
    hipError_t e = hipLaunchCooperativeKernel((const void*)hymba_fwd, dim3(grid), dim3(NTHREADS), args, LDS_BYTES, stream);
    if (e != hipSuccess) fprintf(stderr, "cooperative launch failed: %s (grid %d)\n", hipGetErrorString(e), grid);
#else
    for (int ph = 0; ph < 8; ++ph) { p.sched = (unsigned long long)ph; p.nsteps = 1; p.extra_syncs = 0; hipLaunchKernelGGL(hymba_fwd, dim3(grid), dim3(NTHREADS), LDS_BYTES, stream, p); }
#endif
}
```
